# Optimizing an MI355X kernel written in HIP

```python
import math
import jax, jax.numpy as jnp
from jax import lax
import numpy as np

D_MODEL = 1024
BATCH = 4
SEQ = 4096
DEPTH = 1

HEAD_DIM = 64
N_Q_HEADS = 8
N_KV_HEADS = 2
GQA_GROUP = N_Q_HEADS // N_KV_HEADS
ATTN_WIDTH = N_Q_HEADS * HEAD_DIM
KV_WIDTH = N_KV_HEADS * HEAD_DIM
WINDOW = 128
BLOCK = 128
POOL_WIDTH = D_MODEL - ATTN_WIDTH
POOL_SIZES = (2, 4, 8, 16)
N_POOL_GROUPS = len(POOL_SIZES)
POOL_GROUP_DIM = POOL_WIDTH // N_POOL_GROUPS
IN_WIDTH = ATTN_WIDTH + 2 * KV_WIDTH + POOL_WIDTH
MIX_WIDTH = ATTN_WIDTH + POOL_WIDTH
N_BUCKETS = 32
MAX_DISTANCE = 128
D_FF = -(-8 * D_MODEL // (3 * 256)) * 256
PLE_DIM = 256
EPS = 1e-6

kernel_name = "hymba_swa_sink_pool_hybrid"


def rmsnorm(x, g):
    xf = x.astype(jnp.float32)
    y = xf * lax.rsqrt(jnp.mean(xf * xf, axis=-1, keepdims=True) + EPS)
    return (y * g.astype(jnp.float32)).astype(x.dtype)


def t5_causal_bucket(dist):
    n = np.maximum(dist, 0)
    max_exact = N_BUCKETS // 2
    nf = np.maximum(n, 1).astype(np.float64)
    large = max_exact + (np.log(nf / max_exact) / math.log(MAX_DISTANCE / max_exact)
                         * (N_BUCKETS - max_exact)).astype(np.int64)
    large = np.minimum(large, N_BUCKETS - 1)
    return np.where(n < max_exact, n, large).astype(np.int32)


def sliding_window_sink_attention(q, k, v, sinks, rel_bias):
    B, S = q.shape[0], q.shape[1]
    nb = S // BLOCK
    qb = q.reshape(B, nb, BLOCK, N_KV_HEADS, GQA_GROUP, HEAD_DIM)
    kb = k.reshape(B, nb, BLOCK, N_KV_HEADS, HEAD_DIM)
    vb = v.reshape(B, nb, BLOCK, N_KV_HEADS, HEAD_DIM)
    pad = ((0, 0), (1, 0), (0, 0), (0, 0), (0, 0))
    k2 = jnp.concatenate([jnp.pad(kb, pad)[:, :-1], kb], axis=2)
    v2 = jnp.concatenate([jnp.pad(vb, pad)[:, :-1], vb], axis=2)

    logits = jnp.einsum('bnqhgd,bnkhd->bnhgqk', qb, k2).astype(jnp.float32) * (HEAD_DIM ** -0.5)

    i_idx = np.arange(BLOCK)[:, None]
    j_idx = np.arange(2 * BLOCK)[None, :]
    d = BLOCK + i_idx - j_idx
    bucket = t5_causal_bucket(d)
    bias = rel_bias.astype(jnp.float32)[bucket]
    bias = jnp.transpose(bias, (2, 0, 1)).reshape(N_KV_HEADS, GQA_GROUP, BLOCK, 2 * BLOCK)

    rel_ok = (d >= 0) & (d < WINDOW)
    blk_ok = (np.arange(nb)[:, None, None] > 0) | (j_idx[None] >= BLOCK)
    mask = jnp.asarray(rel_ok[None] & blk_ok)[None, :, None, None]

    logits = jnp.where(mask, logits + bias, -jnp.inf)
    sink = sinks.astype(jnp.float32).reshape(N_KV_HEADS, GQA_GROUP)[:, :, None, None]
    m = jnp.maximum(jnp.max(logits, axis=-1, keepdims=True), sink)
    pexp = jnp.exp(logits - m)
    probs = pexp / (jnp.sum(pexp, axis=-1, keepdims=True) + jnp.exp(sink - m))
    out = jnp.einsum('bnhgqk,bnkhd->bnqhgd', probs.astype(v.dtype), v2)
    return out.reshape(B, S, N_Q_HEADS * HEAD_DIM)


def multiscale_pool_mixer(u, w_pool, pool_scale):
    B, S = u.shape[0], u.shape[1]
    ug = u.reshape(B, S, N_POOL_GROUPS, POOL_GROUP_DIM).astype(jnp.float32)
    cs = jnp.cumsum(ug, axis=1)
    t1 = jnp.arange(1, S + 1, dtype=jnp.float32)
    outs = []
    for g, w in enumerate(POOL_SIZES):
        c = cs[:, :, g]
        lag = jnp.pad(c, ((0, 0), (w, 0), (0, 0)))[:, :S]
        cnt = jnp.minimum(t1, float(w))[None, :, None]
        outs.append((c - lag) / cnt - ug[:, :, g])
    pooled = jnp.stack(outs, axis=2)
    y = jnp.einsum('bsgc,gcd->bsgd', pooled, w_pool.astype(jnp.float32))
    y = y.reshape(B, S, POOL_WIDTH) * pool_scale.astype(jnp.float32)
    return y.astype(u.dtype)


def setup_inputs(seed: int = 0) -> dict:
    key = jax.random.key(seed)
    ks = jax.random.split(key, 20)
    f32 = jnp.float32
    nrm = lambda k, shape, s: jax.random.normal(k, shape, f32) * s
    return {
        "x": nrm(ks[0], (BATCH, SEQ, D_MODEL), 1.0),
        "p": nrm(ks[1], (DEPTH, BATCH, SEQ, PLE_DIM), 1.0),
        "w_in": nrm(ks[2], (DEPTH, D_MODEL, IN_WIDTH), D_MODEL ** -0.5),
        "w_out": nrm(ks[3], (DEPTH, MIX_WIDTH, D_MODEL), MIX_WIDTH ** -0.5),
        "g_attn_norm": 1.0 + nrm(ks[4], (DEPTH, D_MODEL), 0.05),
        "g_q": 1.0 + nrm(ks[5], (DEPTH, HEAD_DIM), 0.05),
        "g_k": 1.0 + nrm(ks[6], (DEPTH, HEAD_DIM), 0.05),
        "attn_sinks": nrm(ks[7], (DEPTH, N_Q_HEADS), 1.0),
        "rel_bias": nrm(ks[8], (N_BUCKETS, N_Q_HEADS), 0.3),
        "w_pool": nrm(ks[9], (DEPTH, N_POOL_GROUPS, POOL_GROUP_DIM, POOL_GROUP_DIM), POOL_GROUP_DIM ** -0.5),
        "pool_scale": 1.0 + nrm(ks[10], (DEPTH, POOL_WIDTH), 0.1),
        "g_ffn_norm": 1.0 + nrm(ks[11], (DEPTH, D_MODEL), 0.05),
        "w_gate": nrm(ks[12], (DEPTH, D_MODEL, D_FF), D_MODEL ** -0.5),
        "w_up": nrm(ks[13], (DEPTH, D_MODEL, D_FF), D_MODEL ** -0.5),
        "w_down": nrm(ks[14], (DEPTH, D_FF, D_MODEL), D_FF ** -0.5),
        "g_ple_norm": 1.0 + nrm(ks[15], (DEPTH, D_MODEL), 0.05),
        "w_ple_gate": nrm(ks[16], (DEPTH, D_MODEL, D_MODEL), D_MODEL ** -0.5),
        "w_ple_proj": nrm(ks[17], (DEPTH, PLE_DIM, D_MODEL), PLE_DIM ** -0.5),
    }


def reference(x, p, w_in, w_out, g_attn_norm, g_q, g_k, attn_sinks, rel_bias, w_pool, pool_scale,
              g_ffn_norm, w_gate, w_up, w_down, g_ple_norm, w_ple_gate, w_ple_proj):
    B, S = x.shape[0], x.shape[1]
    h = x
    for i in range(DEPTH):
        hn = rmsnorm(h, g_attn_norm[i])
        z = hn @ w_in[i]
        q = z[..., :ATTN_WIDTH]
        k = z[..., ATTN_WIDTH:ATTN_WIDTH + KV_WIDTH]
        v = z[..., ATTN_WIDTH + KV_WIDTH:ATTN_WIDTH + 2 * KV_WIDTH]
        u = z[..., ATTN_WIDTH + 2 * KV_WIDTH:]
        q = rmsnorm(q.reshape(B, S, N_Q_HEADS, HEAD_DIM), g_q[i])
        k = rmsnorm(k.reshape(B, S, N_KV_HEADS, HEAD_DIM), g_k[i])
        v = v.reshape(B, S, N_KV_HEADS, HEAD_DIM)
        a = sliding_window_sink_attention(q, k, v, attn_sinks[i], rel_bias)
        m = multiscale_pool_mixer(u, w_pool[i], pool_scale[i])
        h = h + jnp.concatenate([a, m], axis=-1) @ w_out[i]
        hn = rmsnorm(h, g_ffn_norm[i])
        h = h + (jax.nn.silu(hn @ w_gate[i]) * (hn @ w_up[i])) @ w_down[i]
        gate = jax.nn.sigmoid(rmsnorm(h, g_ple_norm[i]) @ w_ple_gate[i])
        h = h + gate * (p[i] @ w_ple_proj[i])
    return h
```

```cpp
#include <hip/hip_runtime.h>
#include <cstdio>
#include <cmath>

constexpr int NB = 4, S = 4096, D = 1024, M = NB * S;
constexpr int INW = 1280, FF = 2816, PLE = 256;
constexpr float EPS = 1e-6f;

__global__ void rmsnorm_k(const float* __restrict__ x, const float* __restrict__ g, float* __restrict__ out, int rows) {
    const int row = blockIdx.x * 4 + (threadIdx.x >> 6), lane = threadIdx.x & 63;
    if (row >= rows) return;
    const float4* xr = (const float4*)(x + (size_t)row * D);
    float4 v[4]; float s = 0.f;
#pragma unroll
    for (int j = 0; j < 4; ++j) { v[j] = xr[lane + 64 * j]; s += v[j].x * v[j].x + v[j].y * v[j].y + v[j].z * v[j].z + v[j].w * v[j].w; }
#pragma unroll
    for (int o = 1; o < 64; o <<= 1) s += __shfl_xor(s, o);
    const float r = rsqrtf(s * (1.f / D) + EPS);
    float4* orow = (float4*)(out + (size_t)row * D);
#pragma unroll
    for (int j = 0; j < 4; ++j) { const float4 gg = ((const float4*)g)[lane + 64 * j]; float4 o; o.x = v[j].x * r * gg.x; o.y = v[j].y * r * gg.y; o.z = v[j].z * r * gg.z; o.w = v[j].w * r * gg.w; orow[lane + 64 * j] = o; }
}

template <int EPI>
__global__ void __launch_bounds__(256) sgemm_k(const float* __restrict__ A, int lda, const float* __restrict__ Bm, int ldb, float* C, int ldc, int K, const float* R, int ldr, const float* __restrict__ cs) {
    __shared__ float As[8][128 + 4];
    __shared__ float Bs[8][128 + 4];
    const int tid = threadIdx.x, tx = tid & 15, ty = tid >> 4;
    const int m0 = blockIdx.y * 128, n0 = blockIdx.x * 128;
    float acc[8][8];
#pragma unroll
    for (int i = 0; i < 8; ++i)
#pragma unroll
        for (int j = 0; j < 8; ++j) acc[i][j] = 0.f;
    const int ar = tid >> 1, ak = (tid & 1) * 4;
    const int bk = tid >> 5, bc = (tid & 31) * 4;
    for (int k0 = 0; k0 < K; k0 += 8) {
        const float4 av = *(const float4*)(A + (size_t)(m0 + ar) * lda + k0 + ak);
        const float4 bv = *(const float4*)(Bm + (size_t)(k0 + bk) * ldb + n0 + bc);
        As[ak + 0][ar] = av.x; As[ak + 1][ar] = av.y; As[ak + 2][ar] = av.z; As[ak + 3][ar] = av.w;
        *(float4*)&Bs[bk][bc] = bv;
        __syncthreads();
#pragma unroll
        for (int k = 0; k < 8; ++k) {
            float a[8], b[8];
            const float4 a0 = *(const float4*)&As[k][ty * 4], a1 = *(const float4*)&As[k][64 + ty * 4];
            const float4 b0 = *(const float4*)&Bs[k][tx * 4], b1 = *(const float4*)&Bs[k][64 + tx * 4];
            a[0] = a0.x; a[1] = a0.y; a[2] = a0.z; a[3] = a0.w; a[4] = a1.x; a[5] = a1.y; a[6] = a1.z; a[7] = a1.w;
            b[0] = b0.x; b[1] = b0.y; b[2] = b0.z; b[3] = b0.w; b[4] = b1.x; b[5] = b1.y; b[6] = b1.z; b[7] = b1.w;
#pragma unroll
            for (int i = 0; i < 8; ++i)
#pragma unroll
                for (int j = 0; j < 8; ++j) acc[i][j] += a[i] * b[j];
        }
        __syncthreads();
    }
#pragma unroll
    for (int i = 0; i < 8; ++i) {
        const int r = m0 + (i >> 2) * 64 + ty * 4 + (i & 3);
#pragma unroll
        for (int jh = 0; jh < 2; ++jh) {
            const int c = n0 + jh * 64 + tx * 4;
            float4 o; o.x = acc[i][jh * 4 + 0]; o.y = acc[i][jh * 4 + 1]; o.z = acc[i][jh * 4 + 2]; o.w = acc[i][jh * 4 + 3];
            if (EPI == 1) { const float4 rr = *(const float4*)(R + (size_t)r * ldr + c); o.x += rr.x; o.y += rr.y; o.z += rr.z; o.w += rr.w; }
            if (EPI == 2) { const float4 sc = *(const float4*)(cs + c); o.x *= sc.x; o.y *= sc.y; o.z *= sc.z; o.w *= sc.w; }
            *(float4*)(C + (size_t)r * ldc + c) = o;
        }
    }
}

__global__ void qknorm_k(float* z, const float* __restrict__ gq, const float* __restrict__ gk, int rows) {
    const int w = blockIdx.x * 4 + (threadIdx.x >> 6), lane = threadIdx.x & 63;
    const int row = w / 10, hh = w % 10;
    if (row >= rows) return;
    float* p = z + (size_t)row * INW + hh * 64;
    const float v = p[lane]; float s = v * v;
#pragma unroll
    for (int o = 1; o < 64; o <<= 1) s += __shfl_xor(s, o);
    const float r = rsqrtf(s * (1.f / 64.f) + EPS);
    p[lane] = v * r * (hh < 8 ? gq[lane] : gk[lane]);
}

__device__ __forceinline__ int t5_bucket(int d) {
    if (d < 16) return d;
    const int b = 16 + (int)(log2f((float)d * 0.0625f) * (16.0f / 3.0f));
    return b < 31 ? b : 31;
}

__global__ void __launch_bounds__(512) attn_k(const float* __restrict__ z, const float* __restrict__ sinks, const float* __restrict__ rel_bias, float* __restrict__ mix) {
    __shared__ float qs[8][64];
    __shared__ float ps[8][128];
    const int t = blockIdx.x, h = threadIdx.x >> 6, lane = threadIdx.x & 63, kvh = h >> 2;
    qs[h][lane] = z[(size_t)t * INW + h * 64 + lane];
    __syncthreads();
    float sc[2];
#pragma unroll
    for (int i = 0; i < 2; ++i) {
        const int d = lane + 64 * i, kp = t - d; float s = -INFINITY;
        if (kp >= 0) {
            const float* kr = z + (size_t)kp * INW + 512 + kvh * 64; float a = 0.f;
            for (int c = 0; c < 64; ++c) a += qs[h][c] * kr[c];
            s = a * 0.125f + rel_bias[t5_bucket(d) * 8 + h];
        }
        sc[i] = s;
    }
    const float sink = sinks[h];
    float m = fmaxf(sc[0], sc[1]);
#pragma unroll
    for (int o = 1; o < 64; o <<= 1) m = fmaxf(m, __shfl_xor(m, o));
    m = fmaxf(m, sink);
    const float p0 = (sc[0] == -INFINITY) ? 0.f : expf(sc[0] - m), p1 = (sc[1] == -INFINITY) ? 0.f : expf(sc[1] - m);
    float sum = p0 + p1;
#pragma unroll
    for (int o = 1; o < 64; o <<= 1) sum += __shfl_xor(sum, o);
    sum += expf(sink - m);
    const float inv = 1.f / sum;
    ps[h][lane] = p0 * inv; ps[h][lane + 64] = p1 * inv;
    __syncthreads();
    float o = 0.f;
    const int nd = t < 127 ? t + 1 : 128;
    for (int d = 0; d < nd; ++d) o += ps[h][d] * z[(size_t)(t - d) * INW + 640 + kvh * 64 + lane];
    mix[(size_t)t * D + h * 64 + lane] = o;
}

__global__ void pool_k(const float* __restrict__ z, float* __restrict__ pooled) {
    const int idx = blockIdx.x * 256 + threadIdx.x; const int t = idx >> 9, c = idx & 511, g = c >> 7, w = 2 << g;
    const float* u = z + 768 + c;
    const int n = t + 1 < w ? t + 1 : w; float s = 0.f;
    for (int i = 0; i < n; ++i) s += u[(size_t)(t - i) * INW];
    pooled[(size_t)t * 512 + c] = s / (float)n - u[(size_t)t * INW];
}

__global__ void swiglu_k(float* g, const float* __restrict__ u, size_t n4) {
    const size_t i = (size_t)blockIdx.x * 256 + threadIdx.x; if (i >= n4) return;
    float4 a = ((float4*)g)[i]; const float4 b = ((const float4*)u)[i];
    a.x = a.x / (1.f + expf(-a.x)) * b.x; a.y = a.y / (1.f + expf(-a.y)) * b.y; a.z = a.z / (1.f + expf(-a.z)) * b.z; a.w = a.w / (1.f + expf(-a.w)) * b.w;
    ((float4*)g)[i] = a;
}
__global__ void plefin_k(float* h, const float* __restrict__ gate, const float* __restrict__ pe, size_t n4) {
    const size_t i = (size_t)blockIdx.x * 256 + threadIdx.x; if (i >= n4) return;
    float4 a = ((float4*)h)[i]; const float4 g = ((const float4*)gate)[i], p = ((const float4*)pe)[i];
    a.x += p.x / (1.f + expf(-g.x)); a.y += p.y / (1.f + expf(-g.y)); a.z += p.z / (1.f + expf(-g.z)); a.w += p.w / (1.f + expf(-g.w));
    ((float4*)h)[i] = a;
}

template <int EPI>
static void gemm(hipStream_t st, const float* A, int lda, const float* Bm, int ldb, float* C, int ldc, int Mr, int N, int K, const float* R = nullptr, int ldr = 0, const float* cs = nullptr) {
    hipLaunchKernelGGL(sgemm_k<EPI>, dim3(N / 128, Mr / 128), dim3(256), 0, st, A, lda, Bm, ldb, C, ldc, K, R, ldr, cs);
}

extern "C" void kernel_launch(void* const* d_in, const int* in_sizes, int n_in, void* d_out, int out_size, void* d_ws, size_t ws_size, hipStream_t stream) {
    const float* x = (const float*)d_in[0]; const float* p = (const float*)d_in[1];
    const float* w_in = (const float*)d_in[2]; const float* w_out = (const float*)d_in[3];
    const float* g_attn = (const float*)d_in[4]; const float* g_q = (const float*)d_in[5]; const float* g_k = (const float*)d_in[6];
    const float* sinks = (const float*)d_in[7]; const float* rel_bias = (const float*)d_in[8];
    const float* w_pool = (const float*)d_in[9]; const float* pool_scale = (const float*)d_in[10];
    const float* g_ffn = (const float*)d_in[11]; const float* w_gate = (const float*)d_in[12]; const float* w_up = (const float*)d_in[13]; const float* w_down = (const float*)d_in[14];
    const float* g_ple = (const float*)d_in[15]; const float* w_pg = (const float*)d_in[16]; const float* w_pp = (const float*)d_in[17];
    float* out = (float*)d_out;
    float* ws = (float*)d_ws;
    float* hn = ws;
    float* z = hn + (size_t)S * D;
    float* mix = z + (size_t)S * INW;
    float* pooled = mix + (size_t)S * D;
    float* G = pooled + (size_t)S * 512;
    float* U = G + (size_t)S * FF;
    float* gate = U + (size_t)S * FF;
    float* pe = gate + (size_t)S * D;
    for (int b = 0; b < NB; ++b) {
        const float* xb = x + (size_t)b * S * D; float* hb = out + (size_t)b * S * D; const float* pb = p + (size_t)b * S * PLE;
        hipLaunchKernelGGL(rmsnorm_k, dim3(S / 4), dim3(256), 0, stream, xb, g_attn, hn, S);
        gemm<0>(stream, hn, D, w_in, INW, z, INW, S, INW, D);
        hipLaunchKernelGGL(qknorm_k, dim3(S * 10 / 4), dim3(256), 0, stream, z, g_q, g_k, S);
        hipLaunchKernelGGL(attn_k, dim3(S), dim3(512), 0, stream, z, sinks, rel_bias, mix);
        hipLaunchKernelGGL(pool_k, dim3(S * 512 / 256), dim3(256), 0, stream, z, pooled);
        for (int g = 0; g < 4; ++g) gemm<2>(stream, pooled + g * 128, 512, w_pool + (size_t)g * 128 * 128, 128, mix + 512 + g * 128, D, S, 128, 128, nullptr, 0, pool_scale + g * 128);
        gemm<1>(stream, mix, D, w_out, D, hb, D, S, D, D, xb, D);
        hipLaunchKernelGGL(rmsnorm_k, dim3(S / 4), dim3(256), 0, stream, hb, g_ffn, hn, S);
        gemm<0>(stream, hn, D, w_gate, FF, G, FF, S, FF, D);
        gemm<0>(stream, hn, D, w_up, FF, U, FF, S, FF, D);
        hipLaunchKernelGGL(swiglu_k, dim3((unsigned)(((size_t)S * FF / 4 + 255) / 256)), dim3(256), 0, stream, G, U, (size_t)S * FF / 4);
        gemm<1>(stream, G, FF, w_down, D, hb, D, S, D, FF, hb, D);
        hipLaunchKernelGGL(rmsnorm_k, dim3(S / 4), dim3(256), 0, stream, hb, g_ple, hn, S);
        gemm<0>(stream, hn, D, w_pg, D, gate, D, S, D, D);
        gemm<0>(stream, pb, PLE, w_pp, D, pe, D, S, D, PLE);
        hipLaunchKernelGGL(plefin_k, dim3((unsigned)(((size_t)S * D / 4 + 255) / 256)), dim3(256), 0, stream, hb, gate, pe, (size_t)S * D / 4);
    }
}
```

```cpp
#include <hip/hip_runtime.h>
#include <hip/hip_bf16.h>
#include <cstdio>
#include <cstdint>
#include <cmath>
namespace pg8 {
#define PG8_LAS __attribute__((address_space(3)))
typedef unsigned short bf16_t;
typedef short bf16x8 __attribute__((ext_vector_type(8)));
typedef float f32x4 __attribute__((ext_vector_type(4)));
typedef unsigned u32x4 __attribute__((ext_vector_type(4)));
constexpr int BM = 256, BK = 64, HALF = 128, HTB = HALF * BK * 2  , STAGE_BYTES = 8 * HTB, NXCD = 8, WGM = 8;

__host__ __device__ __forceinline__ int lds_byte(int r, int c) { const int st = (r >> 4) * 2 + (c >> 5), rr = r & 15, cc = c & 31, ob = rr * 64 + cc * 2; return st * 1024 + (ob ^ (((ob >> 9) & 1) << 5)); }
__host__ __device__ __forceinline__ void stage_rc(int b, int& R, int& C) { const int st = b / 1024, sb = b % 1024, swz = sb ^ (((sb >> 9) & 1) << 5); R = (st >> 1) * 16 + swz / 64; C = (st & 1) * 32 + (swz % 64) / 2; }
__host__ __device__ __forceinline__ int perm32(int rho) { const int n = rho >> 4, i = rho & 15; return 8 * (i >> 2) + 4 * n + (i & 3); }

struct Unit { int pm, pn; };
struct Gemm { const bf16_t* A; const bf16_t* Bt; int M, N, K; };

struct StaticOrder {
    int nM, nN, nwg, G, c;
    __host__ __device__ void init(int M, int N, int G_, int c_) { nM = M / BM; nN = N / BM; nwg = nM * nN; G = G_; c = c_; }
    __host__ __device__ bool next(int i, Unit& u) const {
        const long L = (long)i * G + c; if (L >= nwg) return false;
        int wgid = (int)L; { const int q = nwg / NXCD, r = nwg % NXCD, xcd = wgid % NXCD, off = wgid / NXCD; wgid = (xcd < r ? xcd * (q + 1) : r * (q + 1) + (xcd - r) * q) + off; }
        const int nig = WGM * nN, gid = wgid / nig, fm = gid * WGM, gsz = (nM - fm) < WGM ? (nM - fm) : WGM;
        u.pm = fm + ((wgid % nig) % gsz); u.pn = (wgid % nig) / gsz; return true;
    }
    __device__ __forceinline__ void a_ready(const Unit&) const {}
    __device__ __forceinline__ void done(const Unit&) const {}
};

__device__ __forceinline__ unsigned cvt_pk_bf16(float lo, float hi) { unsigned r; asm volatile("v_cvt_pk_bf16_f32 %0, %1, %2" : "=v"(r) : "v"(lo), "v"(hi)); return r; }
__device__ __forceinline__ u32x4 pack8(const f32x4 a, const f32x4 b) { u32x4 w; w.x = cvt_pk_bf16(a[0], a[1]); w.y = cvt_pk_bf16(a[2], a[3]); w.z = cvt_pk_bf16(b[0], b[1]); w.w = cvt_pk_bf16(b[2], b[3]); return w; }
__device__ __forceinline__ f32x4 bf_lo4(unsigned a, unsigned b) { return (f32x4){__uint_as_float(a << 16), __uint_as_float(a & 0xffff0000u), __uint_as_float(b << 16), __uint_as_float(b & 0xffff0000u)}; }
__device__ __forceinline__ float quad_sum(float s) { s += __shfl_xor(s, 16); s += __shfl_xor(s, 32); return s; }
constexpr float LOG2E = 1.4426950408889634f;
constexpr float QSCALE = 0.125f * LOG2E;
constexpr float NEPS = 1e-6f;

struct EpiBf16 {
    static constexpr bool PERM = true, AFTER_DRAIN = false;
    bf16_t* O; int ldc;
    __device__ __forceinline__ void operator()(const f32x4 (&acc)[2][2][4][2], const Unit& u, int wr, int wc, int fr, int fq) const {
        const int row0 = u.pm * BM + wr * 64 + fr, col0 = u.pn * BM + wc * 32 + 8 * fq;
#pragma unroll
        for (int ai = 0; ai < 2; ++ai)
#pragma unroll
            for (int m = 0; m < 4; ++m) { bf16_t* rowp = O + (size_t)(row0 + ai * HALF + m * 16) * ldc + col0;
#pragma unroll
                for (int bj = 0; bj < 2; ++bj) *(u32x4*)(rowp + bj * HALF) = pack8(acc[ai][bj][m][0], acc[ai][bj][m][1]); }
    }
};

struct EpiIn {
    static constexpr bool PERM = true, AFTER_DRAIN = false;
    bf16_t *Q, *Kb, *Vb, *U; const float* rstd; const float* gq; const float* gk;
    __device__ __forceinline__ void operator()(const f32x4 (&acc)[2][2][4][2], const Unit& u, int wr, int wc, int fr, int fq) const {
        const int pn = u.pn; const int row0 = u.pm * BM + wr * 64 + fr;
        const int mode = pn < 2 ? 0 : (pn == 2 ? (wc < 2 ? 1 : 2) : 2);
        bf16_t* base; int ldc, colb;
        if (pn < 2) { base = Q; ldc = 512; colb = 256 * pn + 64 * wc; }
        else if (pn == 2) { if (wc < 2) { base = Kb; colb = 64 * wc; } else { base = Vb; colb = 64 * (wc - 2); } ldc = 128; }
        else { base = U; ldc = 512; colb = 256 * (pn - 3) + 64 * wc; }
        f32x4 gv[2][2];
#pragma unroll
        for (int bj = 0; bj < 2; ++bj)
#pragma unroll
            for (int n = 0; n < 2; ++n) {
                gv[bj][n] = (f32x4){1.f, 1.f, 1.f, 1.f};
                if (mode == 0) gv[bj][n] = *(const f32x4*)(gq + 32 * bj + 8 * fq + 4 * n) * QSCALE;
                if (mode == 1) gv[bj][n] = *(const f32x4*)(gk + 32 * bj + 8 * fq + 4 * n);
            }
#pragma unroll
        for (int ai = 0; ai < 2; ++ai)
#pragma unroll
            for (int m = 0; m < 4; ++m) {
                const int row = row0 + ai * HALF + m * 16; const float rs = rstd[row];
                f32x4 v[2][2]; float ss = 0.f;
#pragma unroll
                for (int bj = 0; bj < 2; ++bj)
#pragma unroll
                    for (int n = 0; n < 2; ++n) { v[bj][n] = acc[ai][bj][m][n] * rs; const f32x4 q = v[bj][n] * v[bj][n]; ss += (q[0] + q[1]) + (q[2] + q[3]); }
                if (mode < 2) { ss = quad_sum(ss); const float hr = __builtin_amdgcn_rsqf(ss * (1.f / 64.f) + NEPS);
#pragma unroll
                    for (int bj = 0; bj < 2; ++bj)
#pragma unroll
                        for (int n = 0; n < 2; ++n) v[bj][n] = v[bj][n] * hr * gv[bj][n]; }
                bf16_t* rowp = base + (size_t)row * ldc + colb + 8 * fq;
#pragma unroll
                for (int bj = 0; bj < 2; ++bj) *(u32x4*)(rowp + 32 * bj) = pack8(v[bj][0], v[bj][1]);
            }
    }
};

struct EpiRes {
    static constexpr bool PERM = true, AFTER_DRAIN = false;
    const float* base; float* out; bf16_t* outb; float* ssq;
    __device__ __forceinline__ void operator()(const f32x4 (&acc)[2][2][4][2], const Unit& u, int wr, int wc, int fr, int fq) const {
        const int row0 = u.pm * BM + wr * 64 + fr, col0 = u.pn * BM + wc * 32 + 8 * fq;
#pragma unroll
        for (int ai = 0; ai < 2; ++ai)
#pragma unroll
            for (int m = 0; m < 4; ++m) {
                const int row = row0 + ai * HALF + m * 16; const size_t off = (size_t)row * 1024 + col0; float ss = 0.f;
#pragma unroll
                for (int bj = 0; bj < 2; ++bj) {
                    const f32x4 h0 = *(const f32x4*)(base + off + bj * HALF) + acc[ai][bj][m][0], h1 = *(const f32x4*)(base + off + bj * HALF + 4) + acc[ai][bj][m][1];
                    *(f32x4*)(out + off + bj * HALF) = h0; *(f32x4*)(out + off + bj * HALF + 4) = h1;
                    *(u32x4*)(outb + off + bj * HALF) = pack8(h0, h1);
                    const f32x4 q0 = h0 * h0, q1 = h1 * h1; ss += ((q0[0] + q0[1]) + (q0[2] + q0[3])) + ((q1[0] + q1[1]) + (q1[2] + q1[3]));
                }
                ss = quad_sum(ss);
                if (fq == 0) ssq[(size_t)row * 16 + 4 * u.pn + wc] = ss;
                if (m & 1) asm volatile("" ::: "memory");
            }
    }
};

__device__ __forceinline__ float row_rstd(const float* ssq, int row, int fq) {
    const f32x4 p = *(const f32x4*)(ssq + (size_t)row * 16 + 4 * fq);
    const float t = quad_sum((p[0] + p[1]) + (p[2] + p[3]));
    return __builtin_amdgcn_rsqf(t * (1.f / 1024.f) + NEPS);
}

struct EpiGU {
    static constexpr bool PERM = true, AFTER_DRAIN = false;
    bf16_t* F; int ldc; const float* ssq;
    __device__ __forceinline__ void operator()(const f32x4 (&acc)[2][2][4][2], const Unit& u, int wr, int wc, int fr, int fq) const {
        const int row0 = u.pm * BM + wr * 64 + fr, col0 = u.pn * HALF + wc * 32 + 8 * fq;
#pragma unroll
        for (int ai = 0; ai < 2; ++ai)
#pragma unroll
            for (int m = 0; m < 4; ++m) {
                const int row = row0 + ai * HALF + m * 16; const float rs = row_rstd(ssq, row, fq);
                f32x4 f[2];
#pragma unroll
                for (int n = 0; n < 2; ++n) {
                    const f32x4 g = acc[ai][0][m][n] * rs, up = acc[ai][1][m][n] * rs;
#pragma unroll
                    for (int j = 0; j < 4; ++j) f[n][j] = g[j] * __builtin_amdgcn_rcpf(1.f + __builtin_amdgcn_exp2f(-LOG2E * g[j])) * up[j];
                }
                *(u32x4*)(F + (size_t)row * ldc + col0) = pack8(f[0], f[1]);
            }
    }
};

struct EpiFinal {
    static constexpr bool PERM = true, AFTER_DRAIN = false;
    float* out; const bf16_t* pe; const float* ssq;
    __device__ __forceinline__ void operator()(const f32x4 (&acc)[2][2][4][2], const Unit& u, int wr, int wc, int fr, int fq) const {
        const int row0 = u.pm * BM + wr * 64 + fr, col0 = u.pn * BM + wc * 32 + 8 * fq;
#pragma unroll
        for (int ai = 0; ai < 2; ++ai)
#pragma unroll
            for (int m = 0; m < 4; ++m) {
                const int row = row0 + ai * HALF + m * 16; const size_t off = (size_t)row * 1024 + col0; const float rs = row_rstd(ssq, row, fq);
#pragma unroll
                for (int bj = 0; bj < 2; ++bj) {
                    const u32x4 pw = *(const u32x4*)(pe + off + bj * HALF);
                    const f32x4 p0 = bf_lo4(pw.x, pw.y), p1 = bf_lo4(pw.z, pw.w);
                    f32x4 h0 = *(const f32x4*)(out + off + bj * HALF), h1 = *(const f32x4*)(out + off + bj * HALF + 4);
                    const f32x4 a0 = acc[ai][bj][m][0] * rs, a1 = acc[ai][bj][m][1] * rs;
#pragma unroll
                    for (int j = 0; j < 4; ++j) { h0[j] += p0[j] * __builtin_amdgcn_rcpf(1.f + __builtin_amdgcn_exp2f(-LOG2E * a0[j])); h1[j] += p1[j] * __builtin_amdgcn_rcpf(1.f + __builtin_amdgcn_exp2f(-LOG2E * a1[j])); }
                    *(f32x4*)(out + off + bj * HALF) = h0; *(f32x4*)(out + off + bj * HALF + 4) = h1;
                }
                if (m & 1) asm volatile("" ::: "memory");
            }
    }
};

template <class Epi, class Sched, bool ALIGN_EPI = false, bool SP2 = false>
__device__ __forceinline__ void gemm_phase(PG8_LAS unsigned char* lds, const Gemm g, const Sched& S, const Epi& E) {
    const int tid = threadIdx.x, wid = __builtin_amdgcn_readfirstlane(tid >> 6), lane = tid & 63, wr = wid >> 2, wc = wid & 3, fr = lane & 15, fq = lane >> 4;
    const int K = g.K, nt = K / BK;
    unsigned voffA[2], voffB[2];
#pragma unroll
    for (int i = 0; i < 2; ++i) { int R, C; stage_rc(tid * 16 + i * 8192, R, C); const int Rb = Epi::PERM ? ((R & ~31) + perm32(R & 31)) : R;
        voffA[i] = (unsigned)(R * K + C) * 2u; voffB[i] = (unsigned)(Rb * K + C) * 2u; }
    const size_t kstep = (size_t)(BK * 2);
    const size_t hstep = (size_t)HALF * K * 2;
    const size_t tstep = 2 * hstep;
    const unsigned ldsw = (unsigned)wid * 1024u;
    const int aoff = lds_byte(wr * 64 + fr, fq * 8), boff = lds_byte(wc * 32 + fr, fq * 8);
#define PG8_SA(b, h) (((b) * 2 + (h)) * HTB)
#define PG8_SB(b, h) ((4 + (b) * 2 + (h)) * HTB)
#define PG8_STAGE(bufoff, gbase, voff) do { _Pragma("unroll") for (int _i = 0; _i < 2; ++_i) \
        __builtin_amdgcn_global_load_lds((const unsigned*)((const char*)(gbase) + (voff)[_i]), (PG8_LAS unsigned*)(lds + (bufoff) + ldsw + _i * 8192), 16, 0, 0); } while (0)
#define PG8_LDA(dst, b, h) do { _Pragma("unroll") for (int m = 0; m < 4; ++m) _Pragma("unroll") for (int k = 0; k < 2; ++k) dst[m][k] = *(const PG8_LAS bf16x8*)(lds + PG8_SA(b, h) + aoff + m * 2048 + k * 1024); } while (0)
#define PG8_LDB(dst, b, h) do { _Pragma("unroll") for (int n = 0; n < 2; ++n) _Pragma("unroll") for (int k = 0; k < 2; ++k) dst[n][k] = *(const PG8_LAS bf16x8*)(lds + PG8_SB(b, h) + boff + n * 2048 + k * 1024); } while (0)
#define PG8_MMA(ai, bj, At, Bt) do { __builtin_amdgcn_s_setprio(1); _Pragma("unroll") for (int m = 0; m < 4; ++m) _Pragma("unroll") for (int n = 0; n < 2; ++n) _Pragma("unroll") for (int k = 0; k < 2; ++k) \
        acc[ai][bj][m][n] = __builtin_amdgcn_mfma_f32_16x16x32_bf16(Bt[n][k], At[m][k], acc[ai][bj][m][n], 0, 0, 0); __builtin_amdgcn_s_setprio(0); } while (0)
#define PG8_WAIT_V(n) asm volatile("s_waitcnt vmcnt(" #n ")" ::: "memory")
#define PG8_WAIT_L(n) asm volatile("s_waitcnt lgkmcnt(" #n ")" ::: "memory")
#define PG8_BAR __builtin_amdgcn_s_barrier()
#define PG8_SCHED __builtin_amdgcn_sched_barrier(0)
    Unit cur, nxt; int ui = 0;
    if (!S.next(0, cur)) return;
    f32x4 acc[2][2][4][2];
#pragma unroll
    for (int a = 0; a < 2; ++a)
#pragma unroll
        for (int b = 0; b < 2; ++b)
#pragma unroll
            for (int m = 0; m < 4; ++m)
#pragma unroll
                for (int n = 0; n < 2; ++n) acc[a][b][m][n] = (f32x4){0.f, 0.f, 0.f, 0.f};
    bf16x8 At[4][2], B0[2][2], B1[2][2];
    const char* cA = (const char*)g.A + (size_t)cur.pm * tstep; const char* cB = (const char*)g.Bt + (size_t)cur.pn * tstep;
    S.a_ready(cur);
    if constexpr (SP2) {
        PG8_STAGE(PG8_SB(0, 0), cB, voffB); PG8_STAGE(PG8_SB(0, 1), cB + hstep, voffB); PG8_STAGE(PG8_SA(0, 0), cA, voffA); PG8_STAGE(PG8_SA(0, 1), cA + hstep, voffA);
        if (wr == 1) PG8_BAR;
        PG8_WAIT_V(2); PG8_BAR;
        PG8_STAGE(PG8_SB(1, 0), cB + kstep, voffB); PG8_STAGE(PG8_SA(1, 0), cA + kstep, voffA); PG8_STAGE(PG8_SB(1, 1), cB + hstep + kstep, voffB);
        PG8_WAIT_V(6); PG8_BAR;
    } else {
        PG8_STAGE(PG8_SB(0, 0), cB, voffB); PG8_STAGE(PG8_SA(0, 0), cA, voffA); PG8_STAGE(PG8_SB(0, 1), cB + hstep, voffB); PG8_STAGE(PG8_SA(0, 1), cA + hstep, voffA);
        if (wr == 1) PG8_BAR;
        PG8_WAIT_V(4); PG8_BAR;
        PG8_STAGE(PG8_SB(1, 0), cB + kstep, voffB); PG8_STAGE(PG8_SA(1, 0), cA + kstep, voffA); PG8_STAGE(PG8_SB(1, 1), cB + hstep + kstep, voffB);
        PG8_WAIT_V(6); PG8_BAR;
    }
    for (;;) {
        const bool has_next = S.next(ui + 1, nxt);
        const char* nA = has_next ? (const char*)g.A + (size_t)nxt.pm * tstep : cA; const char* nB = has_next ? (const char*)g.Bt + (size_t)nxt.pn * tstep : cB;
        for (int t = 0; t < nt; t += 2) {
            const bool last = (t == nt - 2);
            const char* a1 = cA + (size_t)(t + 1) * kstep;
            const char* a2 = last ? nA : cA + (size_t)(t + 2) * kstep; const char* b2 = last ? nB : cB + (size_t)(t + 2) * kstep;
            const char* a3 = a2 + kstep; const char* b3 = b2 + kstep;
            if (last && has_next) S.a_ready(nxt);
            if constexpr (SP2) {
            PG8_LDB(B0, 0, 0); PG8_LDB(B1, 0, 1); PG8_SCHED; PG8_LDA(At, 0, 0); PG8_STAGE(PG8_SA(1, 1), a1 + hstep, voffA);
            PG8_WAIT_V(8); PG8_WAIT_L(0); PG8_BAR; PG8_MMA(0, 0, At, B0); PG8_MMA(0, 1, At, B1); PG8_BAR; PG8_SCHED;
            PG8_LDA(At, 0, 1); PG8_STAGE(PG8_SB(0, 0), b2, voffB); PG8_STAGE(PG8_SB(0, 1), b2 + hstep, voffB); PG8_STAGE(PG8_SA(0, 0), a2, voffA);
            PG8_WAIT_V(8); PG8_WAIT_L(0); PG8_BAR; PG8_MMA(1, 0, At, B0); PG8_MMA(1, 1, At, B1); PG8_BAR; PG8_SCHED;
            PG8_LDB(B0, 1, 0); PG8_LDB(B1, 1, 1); PG8_SCHED; PG8_LDA(At, 1, 0); PG8_STAGE(PG8_SA(0, 1), a2 + hstep, voffA);
            PG8_WAIT_V(8); PG8_WAIT_L(0); PG8_BAR; PG8_MMA(0, 0, At, B0); PG8_MMA(0, 1, At, B1); PG8_BAR; PG8_SCHED;
            PG8_LDA(At, 1, 1); PG8_STAGE(PG8_SB(1, 0), b3, voffB); PG8_STAGE(PG8_SB(1, 1), b3 + hstep, voffB); PG8_STAGE(PG8_SA(1, 0), a3, voffA);
            PG8_WAIT_V(8); PG8_WAIT_L(0); PG8_BAR; PG8_MMA(1, 0, At, B0); PG8_MMA(1, 1, At, B1); PG8_BAR; PG8_SCHED;
            } else {
            PG8_LDB(B0, 0, 0); PG8_SCHED; PG8_LDA(At, 0, 0); PG8_STAGE(PG8_SA(1, 1), a1 + hstep, voffA);
            PG8_WAIT_L(8); PG8_BAR; PG8_WAIT_L(0); PG8_MMA(0, 0, At, B0); PG8_BAR; PG8_SCHED;
            PG8_LDB(B1, 0, 1); PG8_STAGE(PG8_SB(0, 0), b2, voffB);
            PG8_BAR; PG8_WAIT_L(0); PG8_MMA(0, 1, At, B1); PG8_BAR;
            PG8_LDA(At, 0, 1); PG8_STAGE(PG8_SA(0, 0), a2, voffA);
            PG8_BAR; PG8_WAIT_L(0); PG8_MMA(1, 0, At, B0); PG8_BAR; PG8_SCHED;
            PG8_STAGE(PG8_SB(0, 1), b2 + hstep, voffB);
            PG8_WAIT_V(6); PG8_BAR; PG8_MMA(1, 1, At, B1); PG8_BAR;
            PG8_LDB(B0, 1, 0); PG8_SCHED; PG8_LDA(At, 1, 0); PG8_STAGE(PG8_SA(0, 1), a2 + hstep, voffA);
            PG8_WAIT_L(8); PG8_BAR; PG8_WAIT_L(0); PG8_MMA(0, 0, At, B0); PG8_BAR; PG8_SCHED;
            PG8_LDB(B1, 1, 1); PG8_STAGE(PG8_SB(1, 0), b3, voffB);
            PG8_BAR; PG8_WAIT_L(0); PG8_MMA(0, 1, At, B1); PG8_BAR;
            PG8_LDA(At, 1, 1); PG8_STAGE(PG8_SA(1, 0), a3, voffA);
            PG8_BAR; PG8_WAIT_L(0); PG8_MMA(1, 0, At, B0); PG8_BAR; PG8_SCHED;
            PG8_STAGE(PG8_SB(1, 1), b3 + hstep, voffB);
            PG8_WAIT_V(6); PG8_BAR; PG8_MMA(1, 1, At, B1); PG8_BAR;
            }
        }
        if constexpr (ALIGN_EPI) { if (wr == 0) PG8_BAR; }
        if constexpr (!Epi::AFTER_DRAIN) { E(acc, cur, wr, wc, fr, fq); S.done(cur); }
        if (!has_next) break;
#pragma unroll
        for (int a = 0; a < 2; ++a)
#pragma unroll
            for (int b = 0; b < 2; ++b)
#pragma unroll
                for (int m = 0; m < 4; ++m)
#pragma unroll
                    for (int n = 0; n < 2; ++n) acc[a][b][m][n] = (f32x4){0.f, 0.f, 0.f, 0.f};
        cur = nxt; cA = nA; cB = nB; ++ui;
        if constexpr (ALIGN_EPI) { if (wr == 1) PG8_BAR; }
    }
    PG8_WAIT_V(0);
    if constexpr (!ALIGN_EPI) { if (wr == 0) PG8_BAR; }
    PG8_BAR;
    if constexpr (Epi::AFTER_DRAIN) { E.fused(acc, cur, wr, wc, fr, fq, lds, wid, lane); S.done(cur); }
#undef PG8_SA
#undef PG8_SB
#undef PG8_STAGE
#undef PG8_LDA
#undef PG8_LDB
#undef PG8_MMA
#undef PG8_WAIT_V
#undef PG8_WAIT_L
#undef PG8_BAR
#undef PG8_SCHED
}
}

#ifndef PG8_SP2
#define PG8_SP2 true
#endif
#ifndef PG8_ALIGN
#define PG8_ALIGN true
#endif

namespace att {
using bf16 = unsigned short;
using bf16x8 = __attribute__((ext_vector_type(8))) short;
using s16x4 = __attribute__((ext_vector_type(4))) short;
using f32x16 = __attribute__((ext_vector_type(16))) float;
using u32x4 = __attribute__((ext_vector_type(4))) unsigned;
typedef __attribute__((address_space(3))) const char* lds_cptr;
typedef __attribute__((address_space(3))) char* lds_ptr;
typedef short v4i16_t __attribute__((ext_vector_type(4)));
constexpr int SEQ = 4096, NITEMS = 4 * 2 * (SEQ / 64);
constexpr int KVP = 128;
constexpr int BUFB = 49152;
constexpr int OST_OFF = 2 * BUFB;
constexpr int WSF_OFF = OST_OFF + 32768;
constexpr int BT_OFF = 135168;
constexpr int BT_LEN = 260, BT_PAD = 68;
__device__ __forceinline__ int crow(int r, int hi) { return (r & 3) + 8 * (r >> 2) + 4 * hi; }
__device__ __forceinline__ void glds16(const void* gsrc, unsigned lds_dst) { unsigned keep;
    asm volatile("s_mov_b32 %0, m0\n\ts_mov_b32 m0, %2\n\ts_nop 0\n\tglobal_load_lds_dwordx4 %1, off\n\ts_mov_b32 m0, %0" : "=&s"(keep) : "v"(gsrc), "s"(lds_dst) : "memory"); }
__device__ __forceinline__ s16x4 vtr(lds_cptr p) { return __builtin_bit_cast(s16x4, __builtin_amdgcn_ds_read_tr16_b64_v4i16((__attribute__((address_space(3))) v4i16_t*)p)); }
typedef float f32x2_t __attribute__((ext_vector_type(2))); typedef __bf16 bf16x2_t __attribute__((ext_vector_type(2)));
__device__ __forceinline__ unsigned cvtpk_s(float lo, float hi) { f32x2_t v = {lo, hi}; bf16x2_t b = __builtin_convertvector(v, bf16x2_t); return __builtin_bit_cast(unsigned, b); }
__device__ __forceinline__ int t5_bucket(int d) { if (d < 16) return d; const int b = 16 + (int)(log2f((float)d * 0.0625f) * (16.0f / 3.0f)); return b < 31 ? b : 31; }

__device__ __forceinline__ void qkt(f32x16& p0, f32x16& p1, lds_cptr Kslot, const bf16x8* qr, int r32, int hi) {
    const lds_cptr kb = Kslot + hi * 1024 + r32 * 16;
    const f32x16 z = {0.f, 0.f, 0.f, 0.f, 0.f, 0.f, 0.f, 0.f, 0.f, 0.f, 0.f, 0.f, 0.f, 0.f, 0.f, 0.f};
#pragma unroll
    for (int d0 = 0; d0 < 4; ++d0) {
        const bf16x8 b0 = *(const __attribute__((address_space(3))) bf16x8*)(kb + d0 * 2048);
        const bf16x8 b1 = *(const __attribute__((address_space(3))) bf16x8*)(kb + d0 * 2048 + 512);
        if (d0 == 0) { p0 = __builtin_amdgcn_mfma_f32_32x32x16_bf16(b0, qr[0], z, 0, 0, 0); p1 = __builtin_amdgcn_mfma_f32_32x32x16_bf16(b1, qr[0], z, 0, 0, 0); }
        else { p0 = __builtin_amdgcn_mfma_f32_32x32x16_bf16(b0, qr[d0], p0, 0, 0, 0); p1 = __builtin_amdgcn_mfma_f32_32x32x16_bf16(b1, qr[d0], p1, 0, 0, 0); }
    }
}
__device__ __forceinline__ void pv(f32x16* o, lds_cptr vp, const u32x4 (&pw)[4]) {
#pragma unroll
    for (int d0 = 0; d0 < 2; ++d0) {
#pragma unroll
        for (int ks = 0; ks < 4; ++ks) {
            const s16x4 lo = vtr(vp + d0 * 4096 + ks * 1024), hi = vtr(vp + d0 * 4096 + ks * 1024 + 512);
            const bf16x8 vf = (bf16x8){lo[0], lo[1], lo[2], lo[3], hi[0], hi[1], hi[2], hi[3]};
            o[d0] = __builtin_amdgcn_mfma_f32_32x32x16_bf16(__builtin_bit_cast(bf16x8, pw[ks]), vf, o[d0], 0, 0, 0);
        }
    }
}
#define ATT_WAIT_BAR() asm volatile("s_waitcnt vmcnt(0) lgkmcnt(0)\n\ts_barrier" ::: "memory")

__device__ __forceinline__ void attn_phase(lds_ptr lds, const bf16* Q, const bf16* K, const bf16* V, bf16* MIX, const float* rel_bias, const float* sinks, int vcu, int G) {
    const int tid = threadIdx.x, lane = tid & 63, r32 = lane & 31, hi = lane >> 5; const int wid = __builtin_amdgcn_readfirstlane(tid >> 6);
    const unsigned lds0 = (unsigned)(uintptr_t)lds;
    { __attribute__((address_space(3))) float* bt = (__attribute__((address_space(3))) float*)(lds + BT_OFF);
      for (int i = tid; i < 8 * BT_LEN; i += 512) { const int h = i / BT_LEN, d = i % BT_LEN - BT_PAD;
          bt[i] = (d >= 0 && d < 128) ? rel_bias[t5_bucket(d) * 8 + h] * 1.4426950408889634f : -INFINITY; } }
    const int hw = wid >> 1, half = wid & 1;
#define ATT_DECODE(it, b_, kvh_, q0_) const int b_ = (it) >> 7, kvh_ = ((it) >> 6) & 1, q0_ = ((it) & 63) * 64
#define ATT_ISSUE(it, bufoff) do { ATT_DECODE(it, b_, kvh_, q0_); const bf16* Kh_ = K + (size_t)b_ * SEQ * KVP + kvh_ * 64; const bf16* Vh_ = V + (size_t)b_ * SEQ * KVP + kvh_ * 64; \
        _Pragma("unroll") for (int j_ = 0; j_ < 3; ++j_) { int pk_ = q0_ - 128 + 64 * j_ + lane; pk_ = pk_ < 0 ? 0 : pk_; \
            glds16(Kh_ + (size_t)pk_ * KVP + wid * 8, (unsigned)__builtin_amdgcn_readfirstlane(lds0 + (bufoff) + j_ * 8192 + wid * 1024)); \
            int pv_ = q0_ - 128 + 64 * j_ + 16 * (wid & 3) + (lane >> 2); pv_ = pv_ < 0 ? 0 : pv_; \
            glds16(Vh_ + (size_t)pv_ * KVP + (wid >> 2) * 32 + (lane & 3) * 8, (unsigned)__builtin_amdgcn_readfirstlane(lds0 + (bufoff) + 24576 + j_ * 8192 + wid * 1024)); } } while (0)
    int it = vcu; int bufoff = 0;
    if (it < NITEMS) ATT_ISSUE(it, 0);
    for (; it < NITEMS; it += G, bufoff ^= BUFB) {
        ATT_DECODE(it, b, kvh, q0);
        const int h = 4 * kvh + hw;
        const size_t rowq = (size_t)b * SEQ + q0 + 32 * half;
        bf16x8 qr[4];
#pragma unroll
        for (int d0 = 0; d0 < 4; ++d0) qr[d0] = *(const bf16x8*)(Q + (rowq + r32) * 512 + h * 64 + d0 * 16 + hi * 8);
        ATT_WAIT_BAR();
        if (it + G < NITEMS) ATT_ISSUE(it + G, bufoff ^ BUFB);
        const lds_cptr kv = (lds_cptr)lds + bufoff;
        f32x16 p[3][2];
#pragma unroll
        for (int j = 0; j < 3; ++j) qkt(p[j][0], p[j][1], kv + j * 8192, qr, r32, hi);
        const __attribute__((address_space(3))) float* bt = (const __attribute__((address_space(3))) float*)(lds + BT_OFF) + h * BT_LEN + BT_PAD + 128 + 32 * half + r32 - 4 * hi;
#pragma unroll
        for (int j = 0; j < 3; ++j)
#pragma unroll
            for (int hf = 0; hf < 2; ++hf)
#pragma unroll
                for (int r = 0; r < 16; ++r) { const int cst = 64 * j + 32 * hf + (r & 3) + 8 * (r >> 2); p[j][hf][r] += bt[-cst]; }
        if (q0 < 128) {
#pragma unroll
            for (int j = 0; j < 2; ++j)
#pragma unroll
                for (int hf = 0; hf < 2; ++hf)
#pragma unroll
                    for (int r = 0; r < 16; ++r) { const int kk = 64 * j + 32 * hf + crow(r, hi); if (q0 - 128 + kk < 0) p[j][hf][r] = -INFINITY; }
        }
        const float sink2 = sinks[h] * 1.4426950408889634f;
        float mx = sink2;
#pragma unroll
        for (int j = 0; j < 3; ++j)
#pragma unroll
            for (int hf = 0; hf < 2; ++hf)
#pragma unroll
                for (int r = 0; r < 16; ++r) mx = fmaxf(mx, p[j][hf][r]);
        { auto rr = __builtin_amdgcn_permlane32_swap(__float_as_uint(mx), __float_as_uint(mx), false, false); mx = fmaxf(__uint_as_float(rr[0]), __uint_as_float(rr[1])); }
        float l = 0.f;
#pragma unroll
        for (int j = 0; j < 3; ++j)
#pragma unroll
            for (int hf = 0; hf < 2; ++hf)
#pragma unroll
                for (int r = 0; r < 16; ++r) { const float e = __builtin_amdgcn_exp2f(p[j][hf][r] - mx); p[j][hf][r] = e; l += e; }
        { auto rr = __builtin_amdgcn_permlane32_swap(__float_as_uint(l), __float_as_uint(l), false, false); l = __uint_as_float(rr[0]) + __uint_as_float(rr[1]); }
        l += __builtin_amdgcn_exp2f(sink2 - mx);
        f32x16 o[2]; o[0] = f32x16{}; o[1] = f32x16{};
        const lds_cptr vp0 = kv + 24576 + ((lane >> 4) & 1) * 32 + (lane & 3) * 8 + (4 * hi + ((lane & 15) >> 2)) * 64;
#pragma unroll
        for (int j = 0; j < 3; ++j) {
            u32x4 pw[4];
#pragma unroll
            for (int ks = 0; ks < 4; ++ks) { const int hf = ks >> 1, b8 = (ks & 1) * 8;
                pw[ks] = (u32x4){cvtpk_s(p[j][hf][b8 + 0], p[j][hf][b8 + 1]), cvtpk_s(p[j][hf][b8 + 2], p[j][hf][b8 + 3]), cvtpk_s(p[j][hf][b8 + 4], p[j][hf][b8 + 5]), cvtpk_s(p[j][hf][b8 + 6], p[j][hf][b8 + 7])}; }
            pv(o, vp0 + j * 8192, pw);
        }
        __attribute__((address_space(3))) float* wsf = (__attribute__((address_space(3))) float*)(lds + WSF_OFF) + wid * 64;
        if (hi == 0) wsf[r32] = l;
        asm volatile("s_waitcnt lgkmcnt(0)" ::: "memory");
        float rli[16];
#pragma unroll
        for (int r = 0; r < 16; ++r) rli[r] = __builtin_amdgcn_rcpf(wsf[crow(r, hi)]);
        __attribute__((address_space(3))) bf16* stg = (__attribute__((address_space(3))) bf16*)(lds + OST_OFF) + wid * 2048;
#pragma unroll
        for (int r = 0; r < 16; ++r) { const int orow = crow(r, hi);
#pragma unroll
            for (int d0 = 0; d0 < 2; ++d0) stg[orow * 64 + d0 * 32 + r32] = (bf16)(cvtpk_s(o[d0][r] * rli[r], 0.f) & 0xffffu); }
        asm volatile("s_waitcnt lgkmcnt(0)" ::: "memory");
        bf16* Ow = MIX + rowq * 1024 + h * 64;
#pragma unroll
        for (int i = 0; i < 4; ++i) { const int row = i * 8 + (lane >> 3), ch = lane & 7; const u32x4 v = *(const __attribute__((address_space(3))) u32x4*)(stg + row * 64 + ch * 8); *(u32x4*)(Ow + (size_t)row * 1024 + ch * 8) = v; }
        asm volatile("s_waitcnt lgkmcnt(0)" ::: "memory");
    }
    ATT_WAIT_BAR();
#undef ATT_DECODE
#undef ATT_ISSUE
}

template <int W> __device__ __forceinline__ void pool_item(const bf16* U, bf16* MIX, int t, int oc) {
    const int tpos = t & (SEQ - 1);
    float s[8] = {0.f, 0.f, 0.f, 0.f, 0.f, 0.f, 0.f, 0.f}; float u0[8];
#pragma unroll
    for (int i = 0; i < W; ++i) {
        const bool ok = tpos - i >= 0; const int ti = ok ? t - i : t;
        const u32x4 w = *(const u32x4*)(U + (size_t)ti * 512 + oc * 8);
        const float v[8] = {__uint_as_float(w.x << 16), __uint_as_float(w.x & 0xffff0000u), __uint_as_float(w.y << 16), __uint_as_float(w.y & 0xffff0000u),
                            __uint_as_float(w.z << 16), __uint_as_float(w.z & 0xffff0000u), __uint_as_float(w.w << 16), __uint_as_float(w.w & 0xffff0000u)};
#pragma unroll
        for (int e = 0; e < 8; ++e) { if (i == 0) u0[e] = v[e]; s[e] += ok ? v[e] : 0.f; }
    }
    const float inv = 1.f / (float)(tpos + 1 < W ? tpos + 1 : W);
    u32x4 o; o.x = cvtpk_s(s[0] * inv - u0[0], s[1] * inv - u0[1]); o.y = cvtpk_s(s[2] * inv - u0[2], s[3] * inv - u0[3]);
    o.z = cvtpk_s(s[4] * inv - u0[4], s[5] * inv - u0[5]); o.w = cvtpk_s(s[6] * inv - u0[6], s[7] * inv - u0[7]);
    *(u32x4*)(MIX + (size_t)t * 1024 + 512 + oc * 8) = o;
}
__device__ __forceinline__ void pool_phase(const bf16* U, bf16* MIX, int Mrows, int gw, int NGW, int lane) {
    const int nitems = (Mrows / 4) * 4;
    for (int wi = gw; wi < nitems; wi += NGW) {
        const int g = wi & 3, t = (wi >> 2) * 4 + (lane >> 4), oc = g * 16 + (lane & 15);
        if (g == 0) pool_item<2>(U, MIX, t, oc); else if (g == 1) pool_item<4>(U, MIX, t, oc); else if (g == 2) pool_item<8>(U, MIX, t, oc); else pool_item<16>(U, MIX, t, oc);
    }
}
#undef ATT_WAIT_BAR
}

constexpr int NWAVES = 8;
#define GAS __attribute__((address_space(1)))
#define LAS __attribute__((address_space(3)))
typedef unsigned short bf16;
typedef unsigned v4u __attribute__((ext_vector_type(4)));
typedef float f32x4 __attribute__((ext_vector_type(4)));
typedef short bf16x8 __attribute__((ext_vector_type(8)));
typedef GAS unsigned gu32;
typedef GAS unsigned long long gu64;
#define RLX_AGENT __ATOMIC_RELAXED, __HIP_MEMORY_SCOPE_AGENT
#define LDS_WAIT() asm volatile("s_waitcnt lgkmcnt(0)" ::: "memory")
#define VM_WAIT() asm volatile("s_waitcnt vmcnt(0)" ::: "memory")
__device__ __forceinline__ unsigned long long rt() { return __builtin_amdgcn_s_memrealtime(); }
__device__ __forceinline__ unsigned f2bf(float f) { unsigned u = __builtin_bit_cast(unsigned, f); return (u + 0x7fffu + ((u >> 16) & 1u)) >> 16; }
__device__ __forceinline__ unsigned pk2(float lo, float hi) { return f2bf(lo) | (f2bf(hi) << 16); }

#define XB_TMO      128
#define XB_XCNT(j)  (256  + 64 * (j))
#define XB_XSUB(j)  (1280 + 64 * (j))
#define XB_XGEN(j)  (2304 + 64 * (j))
#define XB_TOP      3328
#define XB_TOPGEN   3392
#define XCD_BAR_WORDS 3456
#define XB_SPIN_CAP (1u << 18)

__device__ __forceinline__ unsigned xb_ld(unsigned* p)              { return __hip_atomic_load(p, __ATOMIC_RELAXED, __HIP_MEMORY_SCOPE_AGENT); }
__device__ __forceinline__ unsigned xb_add(unsigned* p, unsigned v) { return __hip_atomic_fetch_add(p, v, __ATOMIC_RELAXED, __HIP_MEMORY_SCOPE_AGENT); }
__device__ __forceinline__ unsigned xb_xcc_id() { return (unsigned)__builtin_amdgcn_s_getreg((3 << 11) | 20) & 0xFu; }
#define XB_SPIN(cond, bar) do { unsigned _sp = 0; while (cond) { __builtin_amdgcn_s_sleep(1); \
    if ((++_sp & 255u) == 0u) { if (xb_ld(&(bar)[XB_TMO])) break; if (_sp > XB_SPIN_CAP) { atomicAdd(&(bar)[XB_TMO], 1u); break; } } } } while (0)

struct XcdBarrier {
    unsigned* bar; unsigned x;
    volatile LAS unsigned* st;
};

__device__ __forceinline__ XcdBarrier xcd_barrier_post(unsigned* bar, volatile LAS unsigned* st) {
    XcdBarrier b; b.bar = bar; b.x = xb_xcc_id(); b.st = st;
    if (threadIdx.x == 0) (void)xb_add(&bar[XB_XCNT(b.x)], 1u);
    return b;
}
__device__ __forceinline__ void xcd_barrier_complete(unsigned* bar, unsigned x, unsigned& nloc, unsigned& nx) {
    const unsigned G = gridDim.x * gridDim.y * gridDim.z;
    unsigned sum, cnt, mine, sp = 0u;
    for (;;) {
        sum = 0u; cnt = 0u; mine = 0u;
#pragma unroll
        for (unsigned j = 0; j < 16; ++j) { const unsigned c = xb_ld(&bar[XB_XCNT(j)]); sum += c; cnt += (c > 0u) ? 1u : 0u; mine = (j == x) ? c : mine; }
        if (sum == G) break;
        __builtin_amdgcn_s_sleep(1);
        if ((++sp & 255u) == 0u) { if (xb_ld(&bar[XB_TMO])) break; if (sp > XB_SPIN_CAP) { atomicAdd(&bar[XB_TMO], 1u); break; } }
    }
    nloc = mine > 0u ? mine : 1u; nx = cnt > 0u ? cnt : 1u;
}

__device__ __forceinline__ void xcd_barrier(const XcdBarrier& b) {
    asm volatile("s_waitcnt vmcnt(0)" ::: "memory");
    __syncthreads();
    if (threadIdx.x == 0) {
        unsigned* bar = b.bar;
        __builtin_amdgcn_s_waitcnt(0);
        unsigned nloc = b.st[0], nx = b.st[1];
        if (nloc == 0u) { xcd_barrier_complete(bar, b.x, nloc, nx); b.st[0] = nloc; b.st[1] = nx; }
        const unsigned old = xb_add(&bar[XB_XSUB(b.x)], 1u);
        const unsigned gen = old / nloc;
        if (old + 1u == (gen + 1u) * nloc) {
            __builtin_amdgcn_fence(__ATOMIC_RELEASE, "agent");
            asm volatile("s_waitcnt vmcnt(0)" ::: "memory");
            const unsigned og = xb_add(&bar[XB_TOP], 1u);
            const unsigned tg = og / nx;
            if (og + 1u == (tg + 1u) * nx) xb_add(&bar[XB_TOPGEN], 1u);
            else XB_SPIN(xb_ld(&bar[XB_TOPGEN]) == tg, bar);
            __builtin_amdgcn_fence(__ATOMIC_ACQUIRE, "agent");
            xb_add(&bar[XB_XGEN(b.x)], 1u);
            asm volatile("s_waitcnt vmcnt(0)" ::: "memory");
        } else {
            XB_SPIN(xb_ld(&bar[XB_XGEN(b.x)]) == gen, bar);
            __builtin_amdgcn_fence(__ATOMIC_ACQUIRE, "agent");
            asm volatile("s_waitcnt vmcnt(0)" ::: "memory");
        }
    }
    __syncthreads();
}

constexpr int NB = 4, SEQ = 4096, D = 1024, M = NB * SEQ, INW = 1280, FF = 2816, PLE = 256;
struct Frame {
    LAS unsigned char* lds;
    volatile LAS unsigned* MISC;
    gu32* ctl;
    int tid, lane, wave;
    int vcu, G;
};

__device__ __forceinline__ void p0_transpose_item(const float* W, int ldw, int k0, int ncol0, bf16* WT, int ldt, int drow0, const float* gk, LAS float* scr, int lane) {
#pragma unroll 8
    for (int i = 0; i < 32; ++i) { const int kk = 2 * i + (lane >> 5); float v = W[(size_t)(k0 + kk) * ldw + ncol0 + (lane & 31)]; if (gk) v *= gk[k0 + kk]; scr[kk * 33 + (lane & 31)] = v; }
    LDS_WAIT(); asm volatile("" ::: "memory");
    const int c = lane & 7;
#pragma unroll
    for (int j = 0; j < 4; ++j) { const int n = (lane >> 3) + 8 * j; const LAS float* s = scr + (8 * c) * 33 + n;
        v4u o; o.x = pk2(s[0 * 33], s[1 * 33]); o.y = pk2(s[2 * 33], s[3 * 33]); o.z = pk2(s[4 * 33], s[5 * 33]); o.w = pk2(s[6 * 33], s[7 * 33]);
        *(GAS v4u*)(WT + (size_t)(drow0 + n) * ldt + k0 + 8 * c) = o; }
    LDS_WAIT(); asm volatile("" ::: "memory");
}
__device__ __forceinline__ float wave_sum(float v) {
#pragma unroll
    for (int o = 1; o < 64; o <<= 1) v += __shfl_xor(v, o);
    return v;
}
struct Ptrs {
    const float *x, *p, *w_in, *w_out, *g_attn, *g_q, *g_k, *sinks, *rel_bias, *w_pool, *pool_scale, *g_ffn, *w_gate, *w_up, *w_down, *g_ple, *w_pg, *w_pp;
    float* out;
    bf16 *Win_t, *Wpp_t, *Wout_t, *Wgu_t, *Wdown_t, *Wpg_t;
    bf16 *AB, *PB, *Qb, *Kb, *Vb, *Ub, *MIX, *PE, *Fb;
    float *rstd1, *ssq2, *ssq3;
};
__device__ __forceinline__ void p0_prologue(const Frame& F, const Ptrs& P) {
    LAS float* scr = (LAS float*)(F.lds + F.wave * 16384);
    const int gw = F.vcu * NWAVES + F.wave, NGW = F.G * NWAVES, lane = F.lane;
    constexpr int I_IN = (D / 64) * (INW / 32), I_PP = (PLE / 64) * (D / 32), I_OUT = (512 / 64) * (D / 32), I_GU = (D / 64) * (2 * FF / 32), I_DN = (FF / 64) * (D / 32), I_PG = (D / 64) * (D / 32);
    constexpr int I_FOLD = 4 * 8 * 16;
    constexpr int NITEMS = I_IN + I_PP + I_OUT + I_GU + I_DN + I_PG + I_FOLD;
    for (int it = gw; it < NITEMS; it += NGW) {
        int r = it;
        if (r < I_IN) { const int nbk = INW / 32, kb = r / nbk, nb = r % nbk, pn = nb >> 3, wi = nb & 7, bj = wi >> 2, wc = wi & 3;
            p0_transpose_item(P.w_in, INW, 64 * kb, 256 * pn + 64 * wc + 32 * bj, P.Win_t, D, 32 * nb, P.g_attn, scr, lane); continue; } r -= I_IN;
        if (r < I_PP) { const int nbk = D / 32, kb = r / nbk, nb = r % nbk; p0_transpose_item(P.w_pp, D, 64 * kb, 32 * nb, P.Wpp_t, PLE, 32 * nb, nullptr, scr, lane); continue; } r -= I_PP;
        if (r < I_OUT) { const int nbk = D / 32, kb = r / nbk, nb = r % nbk; p0_transpose_item(P.w_out, D, 64 * kb, 32 * nb, P.Wout_t, D, 32 * nb, nullptr, scr, lane); continue; } r -= I_OUT;
        if (r < I_GU) { const int nbk = 2 * FF / 32, kb = r / nbk, nb = r % nbk, pn = nb >> 3, wi = nb & 7;
            p0_transpose_item(wi < 4 ? P.w_gate : P.w_up, FF, 64 * kb, 128 * pn + 32 * (wi & 3), P.Wgu_t, D, 32 * nb, P.g_ffn, scr, lane); continue; } r -= I_GU;
        if (r < I_DN) { const int nbk = D / 32, kb = r / nbk, nb = r % nbk; p0_transpose_item(P.w_down, D, 64 * kb, 32 * nb, P.Wdown_t, FF, 32 * nb, nullptr, scr, lane); continue; } r -= I_DN;
        if (r < I_PG) { const int nbk = D / 32, kb = r / nbk, nb = r % nbk; p0_transpose_item(P.w_pg, D, 64 * kb, 32 * nb, P.Wpg_t, D, 32 * nb, P.g_ple, scr, lane); continue; } r -= I_PG;
        {
            const int g = r >> 7, cb = (r >> 4) & 7, nb = r & 15, n = nb * 64 + lane;
            float acc[16];
#pragma unroll
            for (int c = 0; c < 16; ++c) acc[c] = 0.f;
            const float* wp = P.w_pool + (size_t)(g * 128 + cb * 16) * 128; const float* ps = P.pool_scale + g * 128; const float* wo = P.w_out + (size_t)(512 + g * 128) * D + n;
            for (int d = 0; d < 128; ++d) { const float wv = wo[(size_t)d * D] * ps[d];
#pragma unroll
                for (int c = 0; c < 16; ++c) acc[c] += wp[c * 128 + d] * wv; }
            v4u o0, o1; o0.x = pk2(acc[0], acc[1]); o0.y = pk2(acc[2], acc[3]); o0.z = pk2(acc[4], acc[5]); o0.w = pk2(acc[6], acc[7]);
            o1.x = pk2(acc[8], acc[9]); o1.y = pk2(acc[10], acc[11]); o1.z = pk2(acc[12], acc[13]); o1.w = pk2(acc[14], acc[15]);
            GAS v4u* dst = (GAS v4u*)(P.Wout_t + (size_t)n * D + 512 + g * 128 + cb * 16); dst[0] = o0; dst[1] = o1;
        }
    }
    for (int m = gw; m < M; m += NGW) {
        const GAS f32x4* xr = (const GAS f32x4*)(P.x + (size_t)m * D) + lane; f32x4 v[4]; float s = 0.f;
#pragma unroll
        for (int j = 0; j < 4; ++j) { v[j] = xr[64 * j]; s += (v[j].x * v[j].x + v[j].y * v[j].y) + (v[j].z * v[j].z + v[j].w * v[j].w); }
        s = wave_sum(s);
        GAS unsigned long long* o8 = (GAS unsigned long long*)(P.AB + (size_t)m * D) + lane;
#pragma unroll
        for (int j = 0; j < 4; ++j) o8[64 * j] = (unsigned long long)pk2(v[j].x, v[j].y) | ((unsigned long long)pk2(v[j].z, v[j].w) << 32);
        if (lane == 0) P.rstd1[m] = 1.0f / sqrtf(s * (1.f / D) + 1e-6f);
    }
    for (int m = gw; m < M; m += NGW) {
        const f32x4 v = ((const GAS f32x4*)(P.p + (size_t)m * PLE))[lane];
        ((GAS unsigned long long*)(P.PB + (size_t)m * PLE))[lane] = (unsigned long long)pk2(v.x, v.y) | ((unsigned long long)pk2(v.z, v.w) << 32);
    }
}

constexpr size_t MiB = 1u << 20;
constexpr size_t WS_CTL = 0, CTL_ZERO_BYTES = 64 * 1024;
constexpr size_t WS_WIN = 1 * MiB, WS_WPP = WS_WIN + (size_t)INW * D * 2, WS_WOUT = 4 * MiB, WS_WGU = 6 * MiB, WS_WDN = 17 * MiB, WS_WPG = WS_WDN + (size_t)D * FF * 2;
constexpr size_t WS_RSTD1 = 25 * MiB, WS_SSQ2 = 26 * MiB, WS_SSQ3 = 27 * MiB;
constexpr size_t WS_AB = 32 * MiB;
constexpr size_t WS_PB = 64 * MiB;
constexpr size_t WS_PE = 72 * MiB;
constexpr size_t WS_F = 104 * MiB;
constexpr size_t WS_Q = 104 * MiB, WS_K = 120 * MiB, WS_V = 124 * MiB, WS_U = 128 * MiB, WS_MIX = 144 * MiB, WS_END = 192 * MiB;
static_assert(WS_WPP + (size_t)D * PLE * 2 <= WS_WOUT && WS_WPG + (size_t)D * D * 2 <= WS_RSTD1 && WS_F + (size_t)M * FF * 2 <= WS_END && WS_MIX + (size_t)M * D * 2 <= WS_END, "d_ws map");
constexpr int CW_BAR = 4096;
static_assert((CW_BAR + XCD_BAR_WORDS) * 4 <= (int)CTL_ZERO_BYTES, "CTL words inside the memset region");
constexpr int RING_BYTES = 131072;
constexpr int LDSCTL_OFF = RING_BYTES + 2048, MISC_OFF = LDSCTL_OFF + 320;
constexpr int LDS_BYTES = 147456;
static_assert(att::WSF_OFF + 2048 <= LDSCTL_OFF && MISC_OFF + 128 <= att::BT_OFF && att::BT_OFF + 8 * att::BT_LEN * 4 <= LDS_BYTES, "LDS map");

#ifndef MK_N_LAUNCHES
#define MK_N_LAUNCHES 1
#endif
constexpr int N_LAUNCHES = MK_N_LAUNCHES;
constexpr int N_PHASES = 7;

struct Args { Ptrs P; unsigned char* ws; int ph_lo, ph_hi; };
__global__ void __launch_bounds__(NWAVES * 64, 2) hymba_fwd(Args args) {
    extern __shared__ __attribute__((aligned(16))) unsigned char lds[];
    Frame F;
    F.lds = (LAS unsigned char*)lds;
    F.MISC = (volatile LAS unsigned*)(F.lds + MISC_OFF);
    F.tid = threadIdx.x; F.lane = F.tid & 63; F.wave = __builtin_amdgcn_readfirstlane(F.tid >> 6);
    F.G = gridDim.x; { const int bx = blockIdx.x; F.vcu = (F.G % 8 == 0) ? (bx % 8) * (F.G / 8) + bx / 8 : bx; }
    F.ctl = (gu32*)(args.ws + WS_CTL);
    const Ptrs& P = args.P;
    for (int u = F.tid; u < (MISC_OFF + 128 - LDSCTL_OFF) / 4; u += NWAVES * 64) ((LAS unsigned*)(F.lds + LDSCTL_OFF))[u] = 0u;
    __syncthreads();
    XcdBarrier bar; bar.bar = (unsigned*)(F.ctl + CW_BAR); bar.x = 0; bar.st = nullptr;
    if (N_LAUNCHES == 1) bar = xcd_barrier_post((unsigned*)(F.ctl + CW_BAR), F.MISC + 8);
#define GRID_BAR() do { if (N_LAUNCHES == 1) xcd_barrier(bar); } while (0)
    const int lo = args.ph_lo, hi = args.ph_hi;
#define IN(k) (lo <= (k) && (k) < hi)
#define BOTH(k) (IN(k) && IN((k) + 1))
    const int c = (int)blockIdx.x;

    if (IN(0)) { p0_prologue(F, P); if (BOTH(0)) GRID_BAR(); }

    if (IN(1)) {
        { pg8::Gemm g{P.AB, P.Win_t, M, INW, D}; pg8::StaticOrder S; S.init(M, INW, F.G, c);
          pg8::EpiIn E{P.Qb, P.Kb, P.Vb, P.Ub, P.rstd1, P.g_q, P.g_k};
          pg8::gemm_phase<pg8::EpiIn, pg8::StaticOrder, PG8_ALIGN, PG8_SP2>(F.lds, g, S, E); }
        { pg8::Gemm g{P.PB, P.Wpp_t, M, D, PLE}; pg8::StaticOrder S; S.init(M, D, F.G, c);
          pg8::EpiBf16 E{P.PE, D};
          pg8::gemm_phase<pg8::EpiBf16, pg8::StaticOrder, PG8_ALIGN, PG8_SP2>(F.lds, g, S, E); }
        if (BOTH(1)) GRID_BAR();
    }

    if (IN(2)) {
        att::attn_phase((att::lds_ptr)F.lds, P.Qb, P.Kb, P.Vb, P.MIX, P.rel_bias, P.sinks, F.vcu, F.G);
        att::pool_phase(P.Ub, P.MIX, M, F.vcu * NWAVES + F.wave, F.G * NWAVES, F.lane);
        if (BOTH(2)) GRID_BAR();
    }

    if (IN(3)) {
        pg8::Gemm g{P.MIX, P.Wout_t, M, D, D}; pg8::StaticOrder S; S.init(M, D, F.G, c);
        pg8::EpiRes E{P.x, P.out, P.AB, P.ssq2};
        pg8::gemm_phase<pg8::EpiRes, pg8::StaticOrder, PG8_ALIGN, PG8_SP2>(F.lds, g, S, E);
        if (BOTH(3)) GRID_BAR();
    }

    if (IN(4)) {
        pg8::Gemm g{P.AB, P.Wgu_t, M, 2 * FF, D}; pg8::StaticOrder S; S.init(M, 2 * FF, F.G, c);
        pg8::EpiGU E{P.Fb, FF, P.ssq2};
        pg8::gemm_phase<pg8::EpiGU, pg8::StaticOrder, PG8_ALIGN, PG8_SP2>(F.lds, g, S, E);
        if (BOTH(4)) GRID_BAR();
    }

    if (IN(5)) {
        pg8::Gemm g{P.Fb, P.Wdown_t, M, D, FF}; pg8::StaticOrder S; S.init(M, D, F.G, c);
        pg8::EpiRes E{P.out, P.out, P.AB, P.ssq3};
        pg8::gemm_phase<pg8::EpiRes, pg8::StaticOrder, PG8_ALIGN, PG8_SP2>(F.lds, g, S, E);
        if (BOTH(5)) GRID_BAR();
    }

    if (IN(6)) {
        pg8::Gemm g{P.AB, P.Wpg_t, M, D, D}; pg8::StaticOrder S; S.init(M, D, F.G, c);
        pg8::EpiFinal E{P.out, P.PE, P.ssq3};
        pg8::gemm_phase<pg8::EpiFinal, pg8::StaticOrder, PG8_ALIGN, PG8_SP2>(F.lds, g, S, E);
    }
#undef IN
#undef BOTH
#undef GRID_BAR
}

extern "C" void kernel_launch(void* const* d_in, const int* in_sizes, int n_in, void* d_out, int out_size, void* d_ws, size_t ws_size, hipStream_t stream) {
    static int grid = 0;
    if (grid == 0) {
        if (n_in != 18 || in_sizes[0] != M * D || out_size != M * D || ws_size < WS_END) { fprintf(stderr, "kernel_launch: unexpected shapes (n_in %d, in0 %d, out %d, ws %zu); nothing launched\n", n_in, n_in > 0 ? in_sizes[0] : -1, out_size, ws_size); grid = -1; return; }
        int dev = 0, cus = 0, per_cu = 0;
        if (hipGetDevice(&dev) != hipSuccess || hipDeviceGetAttribute(&cus, hipDeviceAttributeMultiprocessorCount, dev) != hipSuccess) { fprintf(stderr, "kernel_launch: device query failed\n"); grid = -1; return; }
        if (hipFuncSetAttribute((const void*)hymba_fwd, hipFuncAttributeMaxDynamicSharedMemorySize, LDS_BYTES) != hipSuccess) { fprintf(stderr, "kernel_launch: hipFuncSetAttribute failed\n"); grid = -1; return; }
        if (hipOccupancyMaxActiveBlocksPerMultiprocessor(&per_cu, (const void*)hymba_fwd, NWAVES * 64, LDS_BYTES) != hipSuccess || per_cu < 1) { fprintf(stderr, "kernel_launch: occupancy query reports %d workgroups per CU\n", per_cu); per_cu = 1; }
        (void)hipGetLastError();
        grid = cus;
    }
    if (grid < 0) return;
    if (N_LAUNCHES == 1) { if (hipMemsetAsync((char*)d_ws + WS_CTL, 0, CTL_ZERO_BYTES, stream) != hipSuccess) { fprintf(stderr, "kernel_launch: hipMemsetAsync failed\n"); return; } }
    Args a{};
    unsigned char* ws = (unsigned char*)d_ws;
    Ptrs& P = a.P;
    P.x = (const float*)d_in[0]; P.p = (const float*)d_in[1]; P.w_in = (const float*)d_in[2]; P.w_out = (const float*)d_in[3]; P.g_attn = (const float*)d_in[4]; P.g_q = (const float*)d_in[5];
    P.g_k = (const float*)d_in[6]; P.sinks = (const float*)d_in[7]; P.rel_bias = (const float*)d_in[8]; P.w_pool = (const float*)d_in[9]; P.pool_scale = (const float*)d_in[10];
    P.g_ffn = (const float*)d_in[11]; P.w_gate = (const float*)d_in[12]; P.w_up = (const float*)d_in[13]; P.w_down = (const float*)d_in[14]; P.g_ple = (const float*)d_in[15];
    P.w_pg = (const float*)d_in[16]; P.w_pp = (const float*)d_in[17]; P.out = (float*)d_out;
    P.Win_t = (bf16*)(ws + WS_WIN); P.Wpp_t = (bf16*)(ws + WS_WPP); P.Wout_t = (bf16*)(ws + WS_WOUT); P.Wgu_t = (bf16*)(ws + WS_WGU); P.Wdown_t = (bf16*)(ws + WS_WDN); P.Wpg_t = (bf16*)(ws + WS_WPG);
    P.AB = (bf16*)(ws + WS_AB); P.PB = (bf16*)(ws + WS_PB); P.Qb = (bf16*)(ws + WS_Q); P.Kb = (bf16*)(ws + WS_K); P.Vb = (bf16*)(ws + WS_V); P.Ub = (bf16*)(ws + WS_U);
    P.MIX = (bf16*)(ws + WS_MIX); P.PE = (bf16*)(ws + WS_PE); P.Fb = (bf16*)(ws + WS_F);
    P.rstd1 = (float*)(ws + WS_RSTD1); P.ssq2 = (float*)(ws + WS_SSQ2); P.ssq3 = (float*)(ws + WS_SSQ3);
    a.ws = ws;
    for (int li = 0; li < N_LAUNCHES; ++li) {
        a.ph_lo = (N_LAUNCHES == 1) ? 0 : li; a.ph_hi = (N_LAUNCHES == 1) ? N_PHASES : li + 1;
        hipLaunchKernelGGL(hymba_fwd, dim3(grid), dim3(NWAVES * 64), LDS_BYTES, stream, a);
        const hipError_t le = hipPeekAtLastError();
        if (le != hipSuccess) { fprintf(stderr, "kernel_launch: launch %d failed: %s\n", li, hipGetErrorName(le)); break; }
    }
}
```

```cpp
#include <hip/hip_runtime.h>
#include <hip/hip_bf16.h>
#include <cstdio>
#include <cstdint>
#include <cmath>
namespace pg8 {
#define PG8_LAS __attribute__((address_space(3)))
typedef unsigned short bf16_t;
typedef short bf16x8 __attribute__((ext_vector_type(8)));
typedef float f32x4 __attribute__((ext_vector_type(4)));
typedef unsigned u32x4 __attribute__((ext_vector_type(4)));
constexpr int BM = 256, BK = 64, HALF = 128, HTB = HALF * BK * 2  , STAGE_BYTES = 8 * HTB, NXCD = 8, WGM = 8;

__host__ __device__ __forceinline__ int lds_byte(int r, int c) { const int st = (r >> 4) * 2 + (c >> 5), rr = r & 15, cc = c & 31, ob = rr * 64 + cc * 2; return st * 1024 + (ob ^ (((ob >> 9) & 1) << 5)); }
__host__ __device__ __forceinline__ void stage_rc(int b, int& R, int& C) { const int st = b / 1024, sb = b % 1024, swz = sb ^ (((sb >> 9) & 1) << 5); R = (st >> 1) * 16 + swz / 64; C = (st & 1) * 32 + (swz % 64) / 2; }
__host__ __device__ __forceinline__ int perm32(int rho) { const int n = rho >> 4, i = rho & 15; return 8 * (i >> 2) + 4 * n + (i & 3); }

struct Unit { int pm, pn; };
struct Gemm { const bf16_t* A; const bf16_t* Bt; int M, N, K; };

struct StaticOrder {
    int nM, nN, nwg, G, c;
    __host__ __device__ void init(int M, int N, int G_, int c_) { nM = M / BM; nN = N / BM; nwg = nM * nN; G = G_; c = c_; }
    __host__ __device__ bool next(int i, Unit& u) const {
        const long L = (long)i * G + c; if (L >= nwg) return false;
        int wgid = (int)L; { const int q = nwg / NXCD, r = nwg % NXCD, xcd = wgid % NXCD, off = wgid / NXCD; wgid = (xcd < r ? xcd * (q + 1) : r * (q + 1) + (xcd - r) * q) + off; }
        const int nig = WGM * nN, gid = wgid / nig, fm = gid * WGM, gsz = (nM - fm) < WGM ? (nM - fm) : WGM;
        u.pm = fm + ((wgid % nig) % gsz); u.pn = (wgid % nig) / gsz; return true;
    }
    __device__ __forceinline__ void a_ready(const Unit&) const {}
    __device__ __forceinline__ void done(const Unit&) const {}
};

__device__ __forceinline__ unsigned cvt_pk_bf16(float lo, float hi) { unsigned r; asm volatile("v_cvt_pk_bf16_f32 %0, %1, %2" : "=v"(r) : "v"(lo), "v"(hi)); return r; }
__device__ __forceinline__ u32x4 pack8(const f32x4 a, const f32x4 b) { u32x4 w; w.x = cvt_pk_bf16(a[0], a[1]); w.y = cvt_pk_bf16(a[2], a[3]); w.z = cvt_pk_bf16(b[0], b[1]); w.w = cvt_pk_bf16(b[2], b[3]); return w; }
__device__ __forceinline__ f32x4 bf_lo4(unsigned a, unsigned b) { return (f32x4){__uint_as_float(a << 16), __uint_as_float(a & 0xffff0000u), __uint_as_float(b << 16), __uint_as_float(b & 0xffff0000u)}; }
__device__ __forceinline__ float quad_sum(float s) { s += __shfl_xor(s, 16); s += __shfl_xor(s, 32); return s; }
constexpr float LOG2E = 1.4426950408889634f;
constexpr float QSCALE = 0.125f * LOG2E;
constexpr float NEPS = 1e-6f;

struct EpiBf16 {
    static constexpr bool PERM = true, AFTER_DRAIN = false;
    bf16_t* O; int ldc;
    __device__ __forceinline__ void operator()(const f32x4 (&acc)[2][2][4][2], const Unit& u, int wr, int wc, int fr, int fq) const {
        const int row0 = u.pm * BM + wr * 64 + fr, col0 = u.pn * BM + wc * 32 + 8 * fq;
#pragma unroll
        for (int ai = 0; ai < 2; ++ai)
#pragma unroll
            for (int m = 0; m < 4; ++m) { bf16_t* rowp = O + (size_t)(row0 + ai * HALF + m * 16) * ldc + col0;
#pragma unroll
                for (int bj = 0; bj < 2; ++bj) *(u32x4*)(rowp + bj * HALF) = pack8(acc[ai][bj][m][0], acc[ai][bj][m][1]); }
    }
};

struct EpiIn {
    static constexpr bool PERM = true, AFTER_DRAIN = false;
    bf16_t *Q, *Kb, *Vb, *U; const float* rstd; const float* gq; const float* gk;
    __device__ __forceinline__ void operator()(const f32x4 (&acc)[2][2][4][2], const Unit& u, int wr, int wc, int fr, int fq) const {
        const int pn = u.pn; const int row0 = u.pm * BM + wr * 64 + fr;
        const int mode = pn < 2 ? 0 : (pn == 2 ? (wc < 2 ? 1 : 2) : 2);
        bf16_t* base; int ldc, colb;
        if (pn < 2) { base = Q; ldc = 512; colb = 256 * pn + 64 * wc; }
        else if (pn == 2) { if (wc < 2) { base = Kb; colb = 64 * wc; } else { base = Vb; colb = 64 * (wc - 2); } ldc = 128; }
        else { base = U; ldc = 512; colb = 256 * (pn - 3) + 64 * wc; }
        f32x4 gv[2][2];
#pragma unroll
        for (int bj = 0; bj < 2; ++bj)
#pragma unroll
            for (int n = 0; n < 2; ++n) {
                gv[bj][n] = (f32x4){1.f, 1.f, 1.f, 1.f};
                if (mode == 0) gv[bj][n] = *(const f32x4*)(gq + 32 * bj + 8 * fq + 4 * n) * QSCALE;
                if (mode == 1) gv[bj][n] = *(const f32x4*)(gk + 32 * bj + 8 * fq + 4 * n);
            }
#pragma unroll
        for (int ai = 0; ai < 2; ++ai)
#pragma unroll
            for (int m = 0; m < 4; ++m) {
                const int row = row0 + ai * HALF + m * 16; const float rs = rstd[row];
                f32x4 v[2][2]; float ss = 0.f;
#pragma unroll
                for (int bj = 0; bj < 2; ++bj)
#pragma unroll
                    for (int n = 0; n < 2; ++n) { v[bj][n] = acc[ai][bj][m][n] * rs; const f32x4 q = v[bj][n] * v[bj][n]; ss += (q[0] + q[1]) + (q[2] + q[3]); }
                if (mode < 2) { ss = quad_sum(ss); const float hr = __builtin_amdgcn_rsqf(ss * (1.f / 64.f) + NEPS);
#pragma unroll
                    for (int bj = 0; bj < 2; ++bj)
#pragma unroll
                        for (int n = 0; n < 2; ++n) v[bj][n] = v[bj][n] * hr * gv[bj][n]; }
                bf16_t* rowp = base + (size_t)row * ldc + colb + 8 * fq;
#pragma unroll
                for (int bj = 0; bj < 2; ++bj) *(u32x4*)(rowp + 32 * bj) = pack8(v[bj][0], v[bj][1]);
            }
    }
};

struct EpiRes {
    static constexpr bool PERM = true, AFTER_DRAIN = false;
    bf16_t* hb; float* ssq;
    __device__ __forceinline__ void operator()(const f32x4 (&acc)[2][2][4][2], const Unit& u, int wr, int wc, int fr, int fq) const {
        const int row0 = u.pm * BM + wr * 64 + fr, col0 = u.pn * BM + wc * 32 + 8 * fq;
#pragma unroll
        for (int ai = 0; ai < 2; ++ai)
#pragma unroll
            for (int m = 0; m < 4; ++m) {
                const int row = row0 + ai * HALF + m * 16; const size_t off = (size_t)row * 1024 + col0; float ss = 0.f;
#pragma unroll
                for (int bj = 0; bj < 2; ++bj) {
                    const u32x4 w = *(const u32x4*)(hb + off + bj * HALF);
                    const f32x4 h0 = bf_lo4(w.x, w.y) + acc[ai][bj][m][0], h1 = bf_lo4(w.z, w.w) + acc[ai][bj][m][1];
                    *(u32x4*)(hb + off + bj * HALF) = pack8(h0, h1);
                    const f32x4 q0 = h0 * h0, q1 = h1 * h1; ss += ((q0[0] + q0[1]) + (q0[2] + q0[3])) + ((q1[0] + q1[1]) + (q1[2] + q1[3]));
                }
                ss = quad_sum(ss);
                if (fq == 0) ssq[(size_t)row * 16 + 4 * u.pn + wc] = ss;
            }
    }
};

__device__ __forceinline__ float row_rstd(const float* ssq, int row, int fq) {
    const f32x4 p = *(const f32x4*)(ssq + (size_t)row * 16 + 4 * fq);
    const float t = quad_sum((p[0] + p[1]) + (p[2] + p[3]));
    return __builtin_amdgcn_rsqf(t * (1.f / 1024.f) + NEPS);
}

struct EpiGU {
    static constexpr bool PERM = true, AFTER_DRAIN = false;
    bf16_t* F; int ldc; const float* ssq;
    __device__ __forceinline__ void operator()(const f32x4 (&acc)[2][2][4][2], const Unit& u, int wr, int wc, int fr, int fq) const {
        const int row0 = u.pm * BM + wr * 64 + fr, col0 = u.pn * HALF + wc * 32 + 8 * fq;
#pragma unroll
        for (int ai = 0; ai < 2; ++ai)
#pragma unroll
            for (int m = 0; m < 4; ++m) {
                const int row = row0 + ai * HALF + m * 16; const float rs = row_rstd(ssq, row, fq);
                f32x4 f[2];
#pragma unroll
                for (int n = 0; n < 2; ++n) {
                    const f32x4 g = acc[ai][0][m][n] * rs, up = acc[ai][1][m][n] * rs;
#pragma unroll
                    for (int j = 0; j < 4; ++j) f[n][j] = g[j] * __builtin_amdgcn_rcpf(1.f + __builtin_amdgcn_exp2f(-LOG2E * g[j])) * up[j];
                }
                *(u32x4*)(F + (size_t)row * ldc + col0) = pack8(f[0], f[1]);
            }
    }
};

struct EpiFinal {
    static constexpr bool PERM = true, AFTER_DRAIN = false;
    float* out; const bf16_t* hb; const bf16_t* pe; const float* ssq;
    __device__ __forceinline__ void operator()(const f32x4 (&acc)[2][2][4][2], const Unit& u, int wr, int wc, int fr, int fq) const {
        const int row0 = u.pm * BM + wr * 64 + fr, col0 = u.pn * BM + wc * 32 + 8 * fq;
#pragma unroll
        for (int ai = 0; ai < 2; ++ai)
#pragma unroll
            for (int m = 0; m < 4; ++m) {
                const int row = row0 + ai * HALF + m * 16; const size_t off = (size_t)row * 1024 + col0; const float rs = row_rstd(ssq, row, fq);
#pragma unroll
                for (int bj = 0; bj < 2; ++bj) {
                    const u32x4 pw = *(const u32x4*)(pe + off + bj * HALF), hw = *(const u32x4*)(hb + off + bj * HALF);
                    const f32x4 p0 = bf_lo4(pw.x, pw.y), p1 = bf_lo4(pw.z, pw.w);
                    f32x4 h0 = bf_lo4(hw.x, hw.y), h1 = bf_lo4(hw.z, hw.w);
                    const f32x4 a0 = acc[ai][bj][m][0] * rs, a1 = acc[ai][bj][m][1] * rs;
#pragma unroll
                    for (int j = 0; j < 4; ++j) { h0[j] += p0[j] * __builtin_amdgcn_rcpf(1.f + __builtin_amdgcn_exp2f(-LOG2E * a0[j])); h1[j] += p1[j] * __builtin_amdgcn_rcpf(1.f + __builtin_amdgcn_exp2f(-LOG2E * a1[j])); }
                    *(f32x4*)(out + off + bj * HALF) = h0; *(f32x4*)(out + off + bj * HALF + 4) = h1;
                }
                if (m & 1) asm volatile("" ::: "memory");
            }
    }
};

template <class Epi, class Sched, bool ALIGN_EPI = false, bool SP2 = false>
__device__ __forceinline__ void gemm_phase(PG8_LAS unsigned char* lds, const Gemm g, const Sched& S, const Epi& E) {
    const int tid = threadIdx.x, wid = __builtin_amdgcn_readfirstlane(tid >> 6), lane = tid & 63, wr = wid >> 2, wc = wid & 3, fr = lane & 15, fq = lane >> 4;
    const int K = g.K, nt = K / BK;
    unsigned voffA[2], voffB[2];
#pragma unroll
    for (int i = 0; i < 2; ++i) { int R, C; stage_rc(tid * 16 + i * 8192, R, C); const int Rb = Epi::PERM ? ((R & ~31) + perm32(R & 31)) : R;
        voffA[i] = (unsigned)(R * K + C) * 2u; voffB[i] = (unsigned)(Rb * K + C) * 2u; }
    const size_t kstep = (size_t)(BK * 2);
    const size_t hstep = (size_t)HALF * K * 2;
    const size_t tstep = 2 * hstep;
    const unsigned ldsw = (unsigned)wid * 1024u;
    const int aoff = lds_byte(wr * 64 + fr, fq * 8), boff = lds_byte(wc * 32 + fr, fq * 8);
#define PG8_SA(b, h) (((b) * 2 + (h)) * HTB)
#define PG8_SB(b, h) ((4 + (b) * 2 + (h)) * HTB)
#define PG8_STAGE(bufoff, gbase, voff) do { _Pragma("unroll") for (int _i = 0; _i < 2; ++_i) \
        __builtin_amdgcn_global_load_lds((const unsigned*)((const char*)(gbase) + (voff)[_i]), (PG8_LAS unsigned*)(lds + (bufoff) + ldsw + _i * 8192), 16, 0, 0); } while (0)
#define PG8_LDA(dst, b, h) do { _Pragma("unroll") for (int m = 0; m < 4; ++m) _Pragma("unroll") for (int k = 0; k < 2; ++k) dst[m][k] = *(const PG8_LAS bf16x8*)(lds + PG8_SA(b, h) + aoff + m * 2048 + k * 1024); } while (0)
#define PG8_LDB(dst, b, h) do { _Pragma("unroll") for (int n = 0; n < 2; ++n) _Pragma("unroll") for (int k = 0; k < 2; ++k) dst[n][k] = *(const PG8_LAS bf16x8*)(lds + PG8_SB(b, h) + boff + n * 2048 + k * 1024); } while (0)
#define PG8_MMA(ai, bj, At, Bt) do { __builtin_amdgcn_s_setprio(1); _Pragma("unroll") for (int m = 0; m < 4; ++m) _Pragma("unroll") for (int n = 0; n < 2; ++n) _Pragma("unroll") for (int k = 0; k < 2; ++k) \
        acc[ai][bj][m][n] = __builtin_amdgcn_mfma_f32_16x16x32_bf16(Bt[n][k], At[m][k], acc[ai][bj][m][n], 0, 0, 0); __builtin_amdgcn_s_setprio(0); } while (0)
#define PG8_WAIT_V(n) asm volatile("s_waitcnt vmcnt(" #n ")" ::: "memory")
#define PG8_WAIT_L(n) asm volatile("s_waitcnt lgkmcnt(" #n ")" ::: "memory")
#define PG8_BAR __builtin_amdgcn_s_barrier()
#define PG8_SCHED __builtin_amdgcn_sched_barrier(0)
    Unit cur, nxt; int ui = 0;
    if (!S.next(0, cur)) return;
    f32x4 acc[2][2][4][2];
#pragma unroll
    for (int a = 0; a < 2; ++a)
#pragma unroll
        for (int b = 0; b < 2; ++b)
#pragma unroll
            for (int m = 0; m < 4; ++m)
#pragma unroll
                for (int n = 0; n < 2; ++n) acc[a][b][m][n] = (f32x4){0.f, 0.f, 0.f, 0.f};
    bf16x8 At[4][2], B0[2][2], B1[2][2];
    const char* cA = (const char*)g.A + (size_t)cur.pm * tstep; const char* cB = (const char*)g.Bt + (size_t)cur.pn * tstep;
    S.a_ready(cur);
    if constexpr (SP2) {
        PG8_STAGE(PG8_SB(0, 0), cB, voffB); PG8_STAGE(PG8_SB(0, 1), cB + hstep, voffB); PG8_STAGE(PG8_SA(0, 0), cA, voffA); PG8_STAGE(PG8_SA(0, 1), cA + hstep, voffA);
        if (wr == 1) PG8_BAR;
        PG8_WAIT_V(2); PG8_BAR;
        PG8_STAGE(PG8_SB(1, 0), cB + kstep, voffB); PG8_STAGE(PG8_SA(1, 0), cA + kstep, voffA); PG8_STAGE(PG8_SB(1, 1), cB + hstep + kstep, voffB);
        PG8_WAIT_V(6); PG8_BAR;
    } else {
        PG8_STAGE(PG8_SB(0, 0), cB, voffB); PG8_STAGE(PG8_SA(0, 0), cA, voffA); PG8_STAGE(PG8_SB(0, 1), cB + hstep, voffB); PG8_STAGE(PG8_SA(0, 1), cA + hstep, voffA);
        if (wr == 1) PG8_BAR;
        PG8_WAIT_V(4); PG8_BAR;
        PG8_STAGE(PG8_SB(1, 0), cB + kstep, voffB); PG8_STAGE(PG8_SA(1, 0), cA + kstep, voffA); PG8_STAGE(PG8_SB(1, 1), cB + hstep + kstep, voffB);
        PG8_WAIT_V(6); PG8_BAR;
    }
    for (;;) {
        const bool has_next = S.next(ui + 1, nxt);
        const char* nA = has_next ? (const char*)g.A + (size_t)nxt.pm * tstep : cA; const char* nB = has_next ? (const char*)g.Bt + (size_t)nxt.pn * tstep : cB;
        for (int t = 0; t < nt; t += 2) {
            const bool last = (t == nt - 2);
            const char* a1 = cA + (size_t)(t + 1) * kstep;
            const char* a2 = last ? nA : cA + (size_t)(t + 2) * kstep; const char* b2 = last ? nB : cB + (size_t)(t + 2) * kstep;
            const char* a3 = a2 + kstep; const char* b3 = b2 + kstep;
            if (last && has_next) S.a_ready(nxt);
            if constexpr (SP2) {
            PG8_LDB(B0, 0, 0); PG8_LDB(B1, 0, 1); PG8_SCHED; PG8_LDA(At, 0, 0); PG8_STAGE(PG8_SA(1, 1), a1 + hstep, voffA);
            PG8_WAIT_V(8); PG8_WAIT_L(0); PG8_BAR; PG8_MMA(0, 0, At, B0); PG8_MMA(0, 1, At, B1); PG8_BAR; PG8_SCHED;
            PG8_LDA(At, 0, 1); PG8_STAGE(PG8_SB(0, 0), b2, voffB); PG8_STAGE(PG8_SB(0, 1), b2 + hstep, voffB); PG8_STAGE(PG8_SA(0, 0), a2, voffA);
            PG8_WAIT_V(8); PG8_WAIT_L(0); PG8_BAR; PG8_MMA(1, 0, At, B0); PG8_MMA(1, 1, At, B1); PG8_BAR; PG8_SCHED;
            PG8_LDB(B0, 1, 0); PG8_LDB(B1, 1, 1); PG8_SCHED; PG8_LDA(At, 1, 0); PG8_STAGE(PG8_SA(0, 1), a2 + hstep, voffA);
            PG8_WAIT_V(8); PG8_WAIT_L(0); PG8_BAR; PG8_MMA(0, 0, At, B0); PG8_MMA(0, 1, At, B1); PG8_BAR; PG8_SCHED;
            PG8_LDA(At, 1, 1); PG8_STAGE(PG8_SB(1, 0), b3, voffB); PG8_STAGE(PG8_SB(1, 1), b3 + hstep, voffB); PG8_STAGE(PG8_SA(1, 0), a3, voffA);
            PG8_WAIT_V(8); PG8_WAIT_L(0); PG8_BAR; PG8_MMA(1, 0, At, B0); PG8_MMA(1, 1, At, B1); PG8_BAR; PG8_SCHED;
            } else {
            PG8_LDB(B0, 0, 0); PG8_SCHED; PG8_LDA(At, 0, 0); PG8_STAGE(PG8_SA(1, 1), a1 + hstep, voffA);
            PG8_WAIT_L(8); PG8_BAR; PG8_WAIT_L(0); PG8_MMA(0, 0, At, B0); PG8_BAR; PG8_SCHED;
            PG8_LDB(B1, 0, 1); PG8_STAGE(PG8_SB(0, 0), b2, voffB);
            PG8_BAR; PG8_WAIT_L(0); PG8_MMA(0, 1, At, B1); PG8_BAR;
            PG8_LDA(At, 0, 1); PG8_STAGE(PG8_SA(0, 0), a2, voffA);
            PG8_BAR; PG8_WAIT_L(0); PG8_MMA(1, 0, At, B0); PG8_BAR; PG8_SCHED;
            PG8_STAGE(PG8_SB(0, 1), b2 + hstep, voffB);
            PG8_WAIT_V(6); PG8_BAR; PG8_MMA(1, 1, At, B1); PG8_BAR;
            PG8_LDB(B0, 1, 0); PG8_SCHED; PG8_LDA(At, 1, 0); PG8_STAGE(PG8_SA(0, 1), a2 + hstep, voffA);
            PG8_WAIT_L(8); PG8_BAR; PG8_WAIT_L(0); PG8_MMA(0, 0, At, B0); PG8_BAR; PG8_SCHED;
            PG8_LDB(B1, 1, 1); PG8_STAGE(PG8_SB(1, 0), b3, voffB);
            PG8_BAR; PG8_WAIT_L(0); PG8_MMA(0, 1, At, B1); PG8_BAR;
            PG8_LDA(At, 1, 1); PG8_STAGE(PG8_SA(1, 0), a3, voffA);
            PG8_BAR; PG8_WAIT_L(0); PG8_MMA(1, 0, At, B0); PG8_BAR; PG8_SCHED;
            PG8_STAGE(PG8_SB(1, 1), b3 + hstep, voffB);
            PG8_WAIT_V(6); PG8_BAR; PG8_MMA(1, 1, At, B1); PG8_BAR;
            }
        }
        if constexpr (ALIGN_EPI) { if (wr == 0) PG8_BAR; }
        if constexpr (!Epi::AFTER_DRAIN) { E(acc, cur, wr, wc, fr, fq); S.done(cur); }
        if (!has_next) break;
#pragma unroll
        for (int a = 0; a < 2; ++a)
#pragma unroll
            for (int b = 0; b < 2; ++b)
#pragma unroll
                for (int m = 0; m < 4; ++m)
#pragma unroll
                    for (int n = 0; n < 2; ++n) acc[a][b][m][n] = (f32x4){0.f, 0.f, 0.f, 0.f};
        cur = nxt; cA = nA; cB = nB; ++ui;
        if constexpr (ALIGN_EPI) { if (wr == 1) PG8_BAR; }
    }
    PG8_WAIT_V(0);
    if constexpr (!ALIGN_EPI) { if (wr == 0) PG8_BAR; }
    PG8_BAR;
    if constexpr (Epi::AFTER_DRAIN) { E.fused(acc, cur, wr, wc, fr, fq, lds, wid, lane); S.done(cur); }
#undef PG8_SA
#undef PG8_SB
#undef PG8_STAGE
#undef PG8_LDA
#undef PG8_LDB
#undef PG8_MMA
#undef PG8_WAIT_V
#undef PG8_WAIT_L
#undef PG8_BAR
#undef PG8_SCHED
}
}

#ifndef PG8_SP2
#define PG8_SP2 true
#endif
#ifndef PG8_ALIGN
#define PG8_ALIGN true
#endif

namespace att {
using bf16 = unsigned short;
using bf16x8 = __attribute__((ext_vector_type(8))) short;
using s16x4 = __attribute__((ext_vector_type(4))) short;
using f32x16 = __attribute__((ext_vector_type(16))) float;
using u32x4 = __attribute__((ext_vector_type(4))) unsigned;
typedef __attribute__((address_space(3))) const char* lds_cptr;
typedef __attribute__((address_space(3))) char* lds_ptr;
typedef short v4i16_t __attribute__((ext_vector_type(4)));
constexpr int SEQ = 4096, NITEMS = 4 * 2 * (SEQ / 64);
constexpr int KVP = 128;
constexpr int BUFB = 49152;
constexpr int OST_OFF = 2 * BUFB;
constexpr int WSF_OFF = OST_OFF + 32768;
constexpr int BT_OFF = 135168;
constexpr int BT_LEN = 260, BT_PAD = 68;
__device__ __forceinline__ int crow(int r, int hi) { return (r & 3) + 8 * (r >> 2) + 4 * hi; }
__device__ __forceinline__ void glds16(const void* gsrc, unsigned lds_dst) { unsigned keep;
    asm volatile("s_mov_b32 %0, m0\n\ts_mov_b32 m0, %2\n\ts_nop 0\n\tglobal_load_lds_dwordx4 %1, off\n\ts_mov_b32 m0, %0" : "=&s"(keep) : "v"(gsrc), "s"(lds_dst) : "memory"); }
__device__ __forceinline__ s16x4 vtr(lds_cptr p) { return __builtin_bit_cast(s16x4, __builtin_amdgcn_ds_read_tr16_b64_v4i16((__attribute__((address_space(3))) v4i16_t*)p)); }
typedef float f32x2_t __attribute__((ext_vector_type(2))); typedef __bf16 bf16x2_t __attribute__((ext_vector_type(2)));
__device__ __forceinline__ unsigned cvtpk_s(float lo, float hi) { f32x2_t v = {lo, hi}; bf16x2_t b = __builtin_convertvector(v, bf16x2_t); return __builtin_bit_cast(unsigned, b); }
__device__ __forceinline__ int t5_bucket(int d) { if (d < 16) return d; const int b = 16 + (int)(log2f((float)d * 0.0625f) * (16.0f / 3.0f)); return b < 31 ? b : 31; }

__device__ __forceinline__ void qkt(f32x16& p0, f32x16& p1, lds_cptr Kslot, const bf16x8* qr, int r32, int hi) {
    const lds_cptr kb = Kslot + hi * 1024 + r32 * 16;
    const f32x16 z = {0.f, 0.f, 0.f, 0.f, 0.f, 0.f, 0.f, 0.f, 0.f, 0.f, 0.f, 0.f, 0.f, 0.f, 0.f, 0.f};
#pragma unroll
    for (int d0 = 0; d0 < 4; ++d0) {
        const bf16x8 b0 = *(const __attribute__((address_space(3))) bf16x8*)(kb + d0 * 2048);
        const bf16x8 b1 = *(const __attribute__((address_space(3))) bf16x8*)(kb + d0 * 2048 + 512);
        if (d0 == 0) { p0 = __builtin_amdgcn_mfma_f32_32x32x16_bf16(b0, qr[0], z, 0, 0, 0); p1 = __builtin_amdgcn_mfma_f32_32x32x16_bf16(b1, qr[0], z, 0, 0, 0); }
        else { p0 = __builtin_amdgcn_mfma_f32_32x32x16_bf16(b0, qr[d0], p0, 0, 0, 0); p1 = __builtin_amdgcn_mfma_f32_32x32x16_bf16(b1, qr[d0], p1, 0, 0, 0); }
    }
}
__device__ __forceinline__ void pv(f32x16* o, lds_cptr vp, const u32x4 (&pw)[4]) {
#pragma unroll
    for (int d0 = 0; d0 < 2; ++d0) {
#pragma unroll
        for (int ks = 0; ks < 4; ++ks) {
            const s16x4 lo = vtr(vp + d0 * 4096 + ks * 1024), hi = vtr(vp + d0 * 4096 + ks * 1024 + 512);
            const bf16x8 vf = (bf16x8){lo[0], lo[1], lo[2], lo[3], hi[0], hi[1], hi[2], hi[3]};
            o[d0] = __builtin_amdgcn_mfma_f32_32x32x16_bf16(__builtin_bit_cast(bf16x8, pw[ks]), vf, o[d0], 0, 0, 0);
        }
    }
}
#define ATT_WAIT_BAR() asm volatile("s_waitcnt vmcnt(0) lgkmcnt(0)\n\ts_barrier" ::: "memory")

__device__ __forceinline__ void attn_phase(lds_ptr lds, const bf16* Q, const bf16* K, const bf16* V, bf16* MIX, const float* rel_bias, const float* sinks, int vcu, int G) {
    const int tid = threadIdx.x, lane = tid & 63, r32 = lane & 31, hi = lane >> 5; const int wid = __builtin_amdgcn_readfirstlane(tid >> 6);
    const unsigned lds0 = (unsigned)(uintptr_t)lds;
    { __attribute__((address_space(3))) float* bt = (__attribute__((address_space(3))) float*)(lds + BT_OFF);
      for (int i = tid; i < 8 * BT_LEN; i += 512) { const int h = i / BT_LEN, d = i % BT_LEN - BT_PAD;
          bt[i] = (d >= 0 && d < 128) ? rel_bias[t5_bucket(d) * 8 + h] * 1.4426950408889634f : -INFINITY; } }
    const int hw = wid >> 1, half = wid & 1;
#define ATT_DECODE(it, b_, kvh_, q0_) const int b_ = (it) >> 7, kvh_ = ((it) >> 6) & 1, q0_ = ((it) & 63) * 64
#define ATT_ISSUE(it, bufoff) do { ATT_DECODE(it, b_, kvh_, q0_); const bf16* Kh_ = K + (size_t)b_ * SEQ * KVP + kvh_ * 64; const bf16* Vh_ = V + (size_t)b_ * SEQ * KVP + kvh_ * 64; \
        _Pragma("unroll") for (int j_ = 0; j_ < 3; ++j_) { int pk_ = q0_ - 128 + 64 * j_ + lane; pk_ = pk_ < 0 ? 0 : pk_; \
            glds16(Kh_ + (size_t)pk_ * KVP + wid * 8, (unsigned)__builtin_amdgcn_readfirstlane(lds0 + (bufoff) + j_ * 8192 + wid * 1024)); \
            int pv_ = q0_ - 128 + 64 * j_ + 16 * (wid & 3) + (lane >> 2); pv_ = pv_ < 0 ? 0 : pv_; \
            glds16(Vh_ + (size_t)pv_ * KVP + (wid >> 2) * 32 + (lane & 3) * 8, (unsigned)__builtin_amdgcn_readfirstlane(lds0 + (bufoff) + 24576 + j_ * 8192 + wid * 1024)); } } while (0)
    int it = vcu; int bufoff = 0;
    if (it < NITEMS) ATT_ISSUE(it, 0);
    for (; it < NITEMS; it += G, bufoff ^= BUFB) {
        ATT_DECODE(it, b, kvh, q0);
        const int h = 4 * kvh + hw;
        const size_t rowq = (size_t)b * SEQ + q0 + 32 * half;
        bf16x8 qr[4];
#pragma unroll
        for (int d0 = 0; d0 < 4; ++d0) qr[d0] = *(const bf16x8*)(Q + (rowq + r32) * 512 + h * 64 + d0 * 16 + hi * 8);
        ATT_WAIT_BAR();
        if (it + G < NITEMS) ATT_ISSUE(it + G, bufoff ^ BUFB);
        const lds_cptr kv = (lds_cptr)lds + bufoff;
        f32x16 p[3][2];
#pragma unroll
        for (int j = 0; j < 3; ++j) qkt(p[j][0], p[j][1], kv + j * 8192, qr, r32, hi);
        const __attribute__((address_space(3))) float* bt = (const __attribute__((address_space(3))) float*)(lds + BT_OFF) + h * BT_LEN + BT_PAD + 128 + 32 * half + r32 - 4 * hi;
#pragma unroll
        for (int j = 0; j < 3; ++j)
#pragma unroll
            for (int hf = 0; hf < 2; ++hf)
#pragma unroll
                for (int r = 0; r < 16; ++r) { const int cst = 64 * j + 32 * hf + (r & 3) + 8 * (r >> 2); p[j][hf][r] += bt[-cst]; }
        if (q0 < 128) {
#pragma unroll
            for (int j = 0; j < 2; ++j)
#pragma unroll
                for (int hf = 0; hf < 2; ++hf)
#pragma unroll
                    for (int r = 0; r < 16; ++r) { const int kk = 64 * j + 32 * hf + crow(r, hi); if (q0 - 128 + kk < 0) p[j][hf][r] = -INFINITY; }
        }
        const float sink2 = sinks[h] * 1.4426950408889634f;
        float mx = sink2;
#pragma unroll
        for (int j = 0; j < 3; ++j)
#pragma unroll
            for (int hf = 0; hf < 2; ++hf)
#pragma unroll
                for (int r = 0; r < 16; ++r) mx = fmaxf(mx, p[j][hf][r]);
        { auto rr = __builtin_amdgcn_permlane32_swap(__float_as_uint(mx), __float_as_uint(mx), false, false); mx = fmaxf(__uint_as_float(rr[0]), __uint_as_float(rr[1])); }
        float l = 0.f;
#pragma unroll
        for (int j = 0; j < 3; ++j)
#pragma unroll
            for (int hf = 0; hf < 2; ++hf)
#pragma unroll
                for (int r = 0; r < 16; ++r) { const float e = __builtin_amdgcn_exp2f(p[j][hf][r] - mx); p[j][hf][r] = e; l += e; }
        { auto rr = __builtin_amdgcn_permlane32_swap(__float_as_uint(l), __float_as_uint(l), false, false); l = __uint_as_float(rr[0]) + __uint_as_float(rr[1]); }
        l += __builtin_amdgcn_exp2f(sink2 - mx);
        f32x16 o[2]; o[0] = f32x16{}; o[1] = f32x16{};
        const lds_cptr vp0 = kv + 24576 + ((lane >> 4) & 1) * 32 + (lane & 3) * 8 + (4 * hi + ((lane & 15) >> 2)) * 64;
#pragma unroll
        for (int j = 0; j < 3; ++j) {
            u32x4 pw[4];
#pragma unroll
            for (int ks = 0; ks < 4; ++ks) { const int hf = ks >> 1, b8 = (ks & 1) * 8;
                pw[ks] = (u32x4){cvtpk_s(p[j][hf][b8 + 0], p[j][hf][b8 + 1]), cvtpk_s(p[j][hf][b8 + 2], p[j][hf][b8 + 3]), cvtpk_s(p[j][hf][b8 + 4], p[j][hf][b8 + 5]), cvtpk_s(p[j][hf][b8 + 6], p[j][hf][b8 + 7])}; }
            pv(o, vp0 + j * 8192, pw);
        }
        __attribute__((address_space(3))) float* wsf = (__attribute__((address_space(3))) float*)(lds + WSF_OFF) + wid * 64;
        if (hi == 0) wsf[r32] = l;
        asm volatile("s_waitcnt lgkmcnt(0)" ::: "memory");
        float rli[16];
#pragma unroll
        for (int r = 0; r < 16; ++r) rli[r] = __builtin_amdgcn_rcpf(wsf[crow(r, hi)]);
        __attribute__((address_space(3))) bf16* stg = (__attribute__((address_space(3))) bf16*)(lds + OST_OFF) + wid * 2048;
#pragma unroll
        for (int r = 0; r < 16; ++r) { const int orow = crow(r, hi);
#pragma unroll
            for (int d0 = 0; d0 < 2; ++d0) stg[orow * 64 + d0 * 32 + r32] = (bf16)(cvtpk_s(o[d0][r] * rli[r], 0.f) & 0xffffu); }
        asm volatile("s_waitcnt lgkmcnt(0)" ::: "memory");
        bf16* Ow = MIX + rowq * 1024 + h * 64;
#pragma unroll
        for (int i = 0; i < 4; ++i) { const int row = i * 8 + (lane >> 3), ch = lane & 7; const u32x4 v = *(const __attribute__((address_space(3))) u32x4*)(stg + row * 64 + ch * 8); *(u32x4*)(Ow + (size_t)row * 1024 + ch * 8) = v; }
        asm volatile("s_waitcnt lgkmcnt(0)" ::: "memory");
    }
    ATT_WAIT_BAR();
#undef ATT_DECODE
#undef ATT_ISSUE
}

template <int W> __device__ __forceinline__ void pool_item(const bf16* U, bf16* MIX, int t, int oc) {
    const int tpos = t & (SEQ - 1);
    float s[8] = {0.f, 0.f, 0.f, 0.f, 0.f, 0.f, 0.f, 0.f}; float u0[8];
#pragma unroll
    for (int i = 0; i < W; ++i) {
        const bool ok = tpos - i >= 0; const int ti = ok ? t - i : t;
        const u32x4 w = *(const u32x4*)(U + (size_t)ti * 512 + oc * 8);
        const float v[8] = {__uint_as_float(w.x << 16), __uint_as_float(w.x & 0xffff0000u), __uint_as_float(w.y << 16), __uint_as_float(w.y & 0xffff0000u),
                            __uint_as_float(w.z << 16), __uint_as_float(w.z & 0xffff0000u), __uint_as_float(w.w << 16), __uint_as_float(w.w & 0xffff0000u)};
#pragma unroll
        for (int e = 0; e < 8; ++e) { if (i == 0) u0[e] = v[e]; s[e] += ok ? v[e] : 0.f; }
    }
    const float inv = 1.f / (float)(tpos + 1 < W ? tpos + 1 : W);
    u32x4 o; o.x = cvtpk_s(s[0] * inv - u0[0], s[1] * inv - u0[1]); o.y = cvtpk_s(s[2] * inv - u0[2], s[3] * inv - u0[3]);
    o.z = cvtpk_s(s[4] * inv - u0[4], s[5] * inv - u0[5]); o.w = cvtpk_s(s[6] * inv - u0[6], s[7] * inv - u0[7]);
    *(u32x4*)(MIX + (size_t)t * 1024 + 512 + oc * 8) = o;
}
__device__ __forceinline__ void pool_phase(const bf16* U, bf16* MIX, int Mrows, int gw, int NGW, int lane) {
    const int nitems = (Mrows / 4) * 4;
    for (int wi = gw; wi < nitems; wi += NGW) {
        const int g = wi & 3, t = (wi >> 2) * 4 + (lane >> 4), oc = g * 16 + (lane & 15);
        if (g == 0) pool_item<2>(U, MIX, t, oc); else if (g == 1) pool_item<4>(U, MIX, t, oc); else if (g == 2) pool_item<8>(U, MIX, t, oc); else pool_item<16>(U, MIX, t, oc);
    }
}
#undef ATT_WAIT_BAR
}

constexpr int NWAVES = 8;
#define GAS __attribute__((address_space(1)))
#define LAS __attribute__((address_space(3)))
typedef unsigned short bf16;
typedef unsigned v4u __attribute__((ext_vector_type(4)));
typedef float f32x4 __attribute__((ext_vector_type(4)));
typedef short bf16x8 __attribute__((ext_vector_type(8)));
typedef GAS unsigned gu32;
typedef GAS unsigned long long gu64;
#define RLX_AGENT __ATOMIC_RELAXED, __HIP_MEMORY_SCOPE_AGENT
#define LDS_WAIT() asm volatile("s_waitcnt lgkmcnt(0)" ::: "memory")
#define VM_WAIT() asm volatile("s_waitcnt vmcnt(0)" ::: "memory")
__device__ __forceinline__ unsigned long long rt() { return __builtin_amdgcn_s_memrealtime(); }
__device__ __forceinline__ unsigned f2bf(float f) { unsigned u = __builtin_bit_cast(unsigned, f); return (u + 0x7fffu + ((u >> 16) & 1u)) >> 16; }
__device__ __forceinline__ unsigned pk2(float lo, float hi) { return f2bf(lo) | (f2bf(hi) << 16); }

#define XB_TMO      128
#define XB_XCNT(j)  (256  + 64 * (j))
#define XB_XSUB(j)  (1280 + 64 * (j))
#define XB_XGEN(j)  (2304 + 64 * (j))
#define XB_TOP      3328
#define XB_TOPGEN   3392
#define XCD_BAR_WORDS 3456
#define XB_SPIN_CAP (1u << 18)

__device__ __forceinline__ unsigned xb_ld(unsigned* p)              { return __hip_atomic_load(p, __ATOMIC_RELAXED, __HIP_MEMORY_SCOPE_AGENT); }
__device__ __forceinline__ unsigned xb_add(unsigned* p, unsigned v) { return __hip_atomic_fetch_add(p, v, __ATOMIC_RELAXED, __HIP_MEMORY_SCOPE_AGENT); }
__device__ __forceinline__ unsigned xb_xcc_id() { return (unsigned)__builtin_amdgcn_s_getreg((3 << 11) | 20) & 0xFu; }
#define XB_SPIN(cond, bar) do { unsigned _sp = 0; while (cond) { __builtin_amdgcn_s_sleep(1); \
    if ((++_sp & 255u) == 0u) { if (xb_ld(&(bar)[XB_TMO])) break; if (_sp > XB_SPIN_CAP) { atomicAdd(&(bar)[XB_TMO], 1u); break; } } } } while (0)

struct XcdBarrier {
    unsigned* bar; unsigned x;
    volatile LAS unsigned* st;
};

__device__ __forceinline__ XcdBarrier xcd_barrier_post(unsigned* bar, volatile LAS unsigned* st) {
    XcdBarrier b; b.bar = bar; b.x = xb_xcc_id(); b.st = st;
    if (threadIdx.x == 0) (void)xb_add(&bar[XB_XCNT(b.x)], 1u);
    return b;
}
__device__ __forceinline__ void xcd_barrier_complete(unsigned* bar, unsigned x, unsigned& nloc, unsigned& nx) {
    const unsigned G = gridDim.x * gridDim.y * gridDim.z;
    unsigned sum, cnt, mine, sp = 0u;
    for (;;) {
        sum = 0u; cnt = 0u; mine = 0u;
#pragma unroll
        for (unsigned j = 0; j < 16; ++j) { const unsigned c = xb_ld(&bar[XB_XCNT(j)]); sum += c; cnt += (c > 0u) ? 1u : 0u; mine = (j == x) ? c : mine; }
        if (sum == G) break;
        __builtin_amdgcn_s_sleep(1);
        if ((++sp & 255u) == 0u) { if (xb_ld(&bar[XB_TMO])) break; if (sp > XB_SPIN_CAP) { atomicAdd(&bar[XB_TMO], 1u); break; } }
    }
    nloc = mine > 0u ? mine : 1u; nx = cnt > 0u ? cnt : 1u;
}

__device__ __forceinline__ void xcd_barrier(const XcdBarrier& b) {
    asm volatile("s_waitcnt vmcnt(0)" ::: "memory");
    __syncthreads();
    if (threadIdx.x == 0) {
        unsigned* bar = b.bar;
        __builtin_amdgcn_s_waitcnt(0);
        unsigned nloc = b.st[0], nx = b.st[1];
        if (nloc == 0u) { xcd_barrier_complete(bar, b.x, nloc, nx); b.st[0] = nloc; b.st[1] = nx; }
        const unsigned old = xb_add(&bar[XB_XSUB(b.x)], 1u);
        const unsigned gen = old / nloc;
        if (old + 1u == (gen + 1u) * nloc) {
            __builtin_amdgcn_fence(__ATOMIC_RELEASE, "agent");
            asm volatile("s_waitcnt vmcnt(0)" ::: "memory");
            const unsigned og = xb_add(&bar[XB_TOP], 1u);
            const unsigned tg = og / nx;
            if (og + 1u == (tg + 1u) * nx) xb_add(&bar[XB_TOPGEN], 1u);
            else XB_SPIN(xb_ld(&bar[XB_TOPGEN]) == tg, bar);
            __builtin_amdgcn_fence(__ATOMIC_ACQUIRE, "agent");
            xb_add(&bar[XB_XGEN(b.x)], 1u);
            asm volatile("s_waitcnt vmcnt(0)" ::: "memory");
        } else {
            XB_SPIN(xb_ld(&bar[XB_XGEN(b.x)]) == gen, bar);
            __builtin_amdgcn_fence(__ATOMIC_ACQUIRE, "agent");
            asm volatile("s_waitcnt vmcnt(0)" ::: "memory");
        }
    }
    __syncthreads();
}

constexpr int NB = 4, SEQ = 4096, D = 1024, M = NB * SEQ, INW = 1280, FF = 2816, PLE = 256;
struct Frame {
    LAS unsigned char* lds;
    volatile LAS unsigned* MISC;
    gu32* ctl;
    int tid, lane, wave;
    int vcu, G;
};

__device__ __forceinline__ void p0_transpose_item(const float* W, int ldw, int k0, int ncol0, bf16* WT, int ldt, int drow0, const float* gk, LAS float* scr, int lane) {
#pragma unroll 16
    for (int i = 0; i < 32; ++i) { const int kk = 2 * i + (lane >> 5); float v = W[(size_t)(k0 + kk) * ldw + ncol0 + (lane & 31)]; if (gk) v *= gk[k0 + kk]; scr[kk * 33 + (lane & 31)] = v; }
    LDS_WAIT(); asm volatile("" ::: "memory");
    const int c = lane & 7;
#pragma unroll
    for (int j = 0; j < 4; ++j) { const int n = (lane >> 3) + 8 * j; const LAS float* s = scr + (8 * c) * 33 + n;
        v4u o; o.x = pk2(s[0 * 33], s[1 * 33]); o.y = pk2(s[2 * 33], s[3 * 33]); o.z = pk2(s[4 * 33], s[5 * 33]); o.w = pk2(s[6 * 33], s[7 * 33]);
        *(GAS v4u*)(WT + (size_t)(drow0 + n) * ldt + k0 + 8 * c) = o; }
    LDS_WAIT(); asm volatile("" ::: "memory");
}
__device__ __forceinline__ float wave_sum(float v) {
#pragma unroll
    for (int o = 1; o < 64; o <<= 1) v += __shfl_xor(v, o);
    return v;
}
struct Ptrs {
    const float *x, *p, *w_in, *w_out, *g_attn, *g_q, *g_k, *sinks, *rel_bias, *w_pool, *pool_scale, *g_ffn, *w_gate, *w_up, *w_down, *g_ple, *w_pg, *w_pp;
    float* out;
    bf16 *Win_t, *Wpp_t, *Wout_t, *Wgu_t, *Wdown_t, *Wpg_t;
    bf16 *AB, *PB, *Qb, *Kb, *Vb, *Ub, *MIX, *PE, *Fb;
    float *rstd1, *ssq2, *ssq3;
};
__device__ __forceinline__ void p0_prologue(const Frame& F, const Ptrs& P) {
    LAS float* scr = (LAS float*)(F.lds + F.wave * 16384);
    const int gw = F.vcu * NWAVES + F.wave, NGW = F.G * NWAVES, lane = F.lane;
    constexpr int I_IN = (D / 64) * (INW / 32), I_PP = (PLE / 64) * (D / 32), I_OUT = (512 / 64) * (D / 32), I_GU = (D / 64) * (2 * FF / 32), I_DN = (FF / 64) * (D / 32), I_PG = (D / 64) * (D / 32);
    constexpr int I_FOLD = 4 * 8 * 16;
    constexpr int NITEMS = I_IN + I_PP + I_OUT + I_GU + I_DN + I_PG + I_FOLD;
    for (int it = gw; it < NITEMS; it += NGW) {
        int r = it;
        if (r < I_IN) { const int nbk = INW / 32, kb = r / nbk, nb = r % nbk, pn = nb >> 3, wi = nb & 7, bj = wi >> 2, wc = wi & 3;
            p0_transpose_item(P.w_in, INW, 64 * kb, 256 * pn + 64 * wc + 32 * bj, P.Win_t, D, 32 * nb, P.g_attn, scr, lane); continue; } r -= I_IN;
        if (r < I_PP) { const int nbk = D / 32, kb = r / nbk, nb = r % nbk; p0_transpose_item(P.w_pp, D, 64 * kb, 32 * nb, P.Wpp_t, PLE, 32 * nb, nullptr, scr, lane); continue; } r -= I_PP;
        if (r < I_OUT) { const int nbk = D / 32, kb = r / nbk, nb = r % nbk; p0_transpose_item(P.w_out, D, 64 * kb, 32 * nb, P.Wout_t, D, 32 * nb, nullptr, scr, lane); continue; } r -= I_OUT;
        if (r < I_GU) { const int nbk = 2 * FF / 32, kb = r / nbk, nb = r % nbk, pn = nb >> 3, wi = nb & 7;
            p0_transpose_item(wi < 4 ? P.w_gate : P.w_up, FF, 64 * kb, 128 * pn + 32 * (wi & 3), P.Wgu_t, D, 32 * nb, P.g_ffn, scr, lane); continue; } r -= I_GU;
        if (r < I_DN) { const int nbk = D / 32, kb = r / nbk, nb = r % nbk; p0_transpose_item(P.w_down, D, 64 * kb, 32 * nb, P.Wdown_t, FF, 32 * nb, nullptr, scr, lane); continue; } r -= I_DN;
        if (r < I_PG) { const int nbk = D / 32, kb = r / nbk, nb = r % nbk; p0_transpose_item(P.w_pg, D, 64 * kb, 32 * nb, P.Wpg_t, D, 32 * nb, P.g_ple, scr, lane); continue; } r -= I_PG;
        {
            const int g = r >> 7, cb = (r >> 4) & 7, nb = r & 15, n = nb * 64 + lane;
            { const GAS f32x4* wp4 = (const GAS f32x4*)(P.w_pool + (size_t)(g * 128 + cb * 16) * 128); const GAS f32x4* ps4 = (const GAS f32x4*)(P.pool_scale + g * 128);
#pragma unroll
              for (int i = 0; i < 8; ++i) { const int q = lane + 64 * i; ((LAS f32x4*)scr)[q] = wp4[q] * ps4[q & 31]; } }
            LDS_WAIT(); asm volatile("" ::: "memory");
            float acc[16];
#pragma unroll
            for (int c = 0; c < 16; ++c) acc[c] = 0.f;
            const float* wo = P.w_out + (size_t)(512 + g * 128) * D + n;
#pragma unroll 2
            for (int d0 = 0; d0 < 128; d0 += 8) {
                float wv[8];
#pragma unroll
                for (int j = 0; j < 8; ++j) wv[j] = wo[(size_t)(d0 + j) * D];
#pragma unroll
                for (int c = 0; c < 16; ++c) { const f32x4 a = ((const LAS f32x4*)scr)[(c * 128 + d0) >> 2], b = ((const LAS f32x4*)scr)[(c * 128 + d0 + 4) >> 2];
                    acc[c] += (a[0] * wv[0] + a[1] * wv[1]) + (a[2] * wv[2] + a[3] * wv[3]) + (b[0] * wv[4] + b[1] * wv[5]) + (b[2] * wv[6] + b[3] * wv[7]); }
            }
            v4u o0, o1; o0.x = pk2(acc[0], acc[1]); o0.y = pk2(acc[2], acc[3]); o0.z = pk2(acc[4], acc[5]); o0.w = pk2(acc[6], acc[7]);
            o1.x = pk2(acc[8], acc[9]); o1.y = pk2(acc[10], acc[11]); o1.z = pk2(acc[12], acc[13]); o1.w = pk2(acc[14], acc[15]);
            GAS v4u* dst = (GAS v4u*)(P.Wout_t + (size_t)n * D + 512 + g * 128 + cb * 16); dst[0] = o0; dst[1] = o1;
            LDS_WAIT(); asm volatile("" ::: "memory");
        }
    }
    for (int m = gw; m < M; m += 2 * NGW) {
        f32x4 v[2][4]; float s[2] = {0.f, 0.f};
#pragma unroll
        for (int h = 0; h < 2; ++h) { const GAS f32x4* xr = (const GAS f32x4*)(P.x + (size_t)(m + h * NGW) * D) + lane;
#pragma unroll
            for (int j = 0; j < 4; ++j) v[h][j] = __builtin_nontemporal_load(xr + 64 * j); }
#pragma unroll
        for (int h = 0; h < 2; ++h) {
#pragma unroll
            for (int j = 0; j < 4; ++j) s[h] += (v[h][j].x * v[h][j].x + v[h][j].y * v[h][j].y) + (v[h][j].z * v[h][j].z + v[h][j].w * v[h][j].w);
            GAS unsigned long long* o8 = (GAS unsigned long long*)(P.AB + (size_t)(m + h * NGW) * D) + lane;
#pragma unroll
            for (int j = 0; j < 4; ++j) o8[64 * j] = (unsigned long long)pk2(v[h][j].x, v[h][j].y) | ((unsigned long long)pk2(v[h][j].z, v[h][j].w) << 32);
        }
        s[0] = wave_sum(s[0]); s[1] = wave_sum(s[1]);
        if (lane == 0) { P.rstd1[m] = 1.0f / sqrtf(s[0] * (1.f / D) + 1e-6f); P.rstd1[m + NGW] = 1.0f / sqrtf(s[1] * (1.f / D) + 1e-6f); }
    }
    for (int m = gw; m < M; m += 4 * NGW) {
        f32x4 v[4];
#pragma unroll
        for (int h = 0; h < 4; ++h) v[h] = __builtin_nontemporal_load((const GAS f32x4*)(P.p + (size_t)(m + h * NGW) * PLE) + lane);
#pragma unroll
        for (int h = 0; h < 4; ++h) ((GAS unsigned long long*)(P.PB + (size_t)(m + h * NGW) * PLE))[lane] = (unsigned long long)pk2(v[h].x, v[h].y) | ((unsigned long long)pk2(v[h].z, v[h].w) << 32);
    }
}

constexpr size_t MiB = 1u << 20;
constexpr size_t WS_CTL = 0, CTL_ZERO_BYTES = 64 * 1024;
constexpr size_t WS_WIN = 1 * MiB, WS_WPP = WS_WIN + (size_t)INW * D * 2, WS_WOUT = 4 * MiB, WS_WGU = 6 * MiB, WS_WDN = 17 * MiB, WS_WPG = WS_WDN + (size_t)D * FF * 2;
constexpr size_t WS_RSTD1 = 25 * MiB, WS_SSQ2 = 26 * MiB, WS_SSQ3 = 27 * MiB;
constexpr size_t WS_AB = 32 * MiB;
constexpr size_t WS_PB = 64 * MiB;
constexpr size_t WS_PE = 72 * MiB;
constexpr size_t WS_F = 104 * MiB;
constexpr size_t WS_Q = 104 * MiB, WS_K = 120 * MiB, WS_V = 124 * MiB, WS_U = 128 * MiB, WS_MIX = 144 * MiB, WS_END = 192 * MiB;
static_assert(WS_WPP + (size_t)D * PLE * 2 <= WS_WOUT && WS_WPG + (size_t)D * D * 2 <= WS_RSTD1 && WS_F + (size_t)M * FF * 2 <= WS_END && WS_MIX + (size_t)M * D * 2 <= WS_END, "d_ws map");
constexpr int CW_BAR = 4096;
static_assert((CW_BAR + XCD_BAR_WORDS) * 4 <= (int)CTL_ZERO_BYTES, "CTL words inside the memset region");
constexpr int RING_BYTES = 131072;
constexpr int LDSCTL_OFF = RING_BYTES + 2048, MISC_OFF = LDSCTL_OFF + 320;
constexpr int LDS_BYTES = 147456;
static_assert(att::WSF_OFF + 2048 <= LDSCTL_OFF && MISC_OFF + 128 <= att::BT_OFF && att::BT_OFF + 8 * att::BT_LEN * 4 <= LDS_BYTES, "LDS map");

#ifndef MK_N_LAUNCHES
#define MK_N_LAUNCHES 1
#endif
constexpr int N_LAUNCHES = MK_N_LAUNCHES;
constexpr int N_PHASES = 7;

#ifndef PROBE_SPIN
#define PROBE_SPIN (-1)
#endif
#ifndef PROBE_ABS
#define PROBE_ABS (-1)
#endif
#ifndef PROBE_SCALE
#define PROBE_SCALE 2.5e-3f
#endif
struct Args { Ptrs P; unsigned char* ws; int ph_lo, ph_hi; };
__global__ void __launch_bounds__(NWAVES * 64, 2) hymba_fwd(Args args) {
    extern __shared__ __attribute__((aligned(16))) unsigned char lds[];
    Frame F;
    F.lds = (LAS unsigned char*)lds;
    F.MISC = (volatile LAS unsigned*)(F.lds + MISC_OFF);
    F.tid = threadIdx.x; F.lane = F.tid & 63; F.wave = __builtin_amdgcn_readfirstlane(F.tid >> 6);
    F.G = gridDim.x; { const int bx = blockIdx.x; F.vcu = (F.G % 8 == 0) ? (bx % 8) * (F.G / 8) + bx / 8 : bx; }
    F.ctl = (gu32*)(args.ws + WS_CTL);
    const Ptrs& P = args.P;
    for (int u = F.tid; u < (MISC_OFF + 128 - LDSCTL_OFF) / 4; u += NWAVES * 64) ((LAS unsigned*)(F.lds + LDSCTL_OFF))[u] = 0u;
    __syncthreads();
    XcdBarrier bar; bar.bar = (unsigned*)(F.ctl + CW_BAR); bar.x = 0; bar.st = nullptr;
    if (N_LAUNCHES == 1) bar = xcd_barrier_post((unsigned*)(F.ctl + CW_BAR), F.MISC + 8);
#define GRID_BAR() do { if (N_LAUNCHES == 1) xcd_barrier(bar); } while (0)
    const int lo = args.ph_lo, hi = args.ph_hi;
#define IN(k) (lo <= (k) && (k) < hi)
#define BOTH(k) (IN(k) && IN((k) + 1))
    const int c = (int)blockIdx.x;
    unsigned long long pt0_ = 0, ptabs_ = 0;
#define PH_BEGIN() do { if (PROBE_SPIN >= 0 || PROBE_ABS >= 0) pt0_ = rt(); } while (0)
#define PH_END(k) do { if (PROBE_SPIN == (k) || PROBE_ABS == (k)) { const unsigned long long t1_ = rt(), dt_ = t1_ - pt0_; if (PROBE_ABS == (k)) ptabs_ = dt_; \
        if (PROBE_SPIN == (k)) { while (rt() - t1_ < dt_) __builtin_amdgcn_s_sleep(8); } } } while (0)

    PH_BEGIN(); if (IN(0)) { p0_prologue(F, P); if (BOTH(0)) GRID_BAR(); } PH_END(0);

    PH_BEGIN(); if (IN(1)) {
        { pg8::Gemm g{P.AB, P.Win_t, M, INW, D}; pg8::StaticOrder S; S.init(M, INW, F.G, c);
          pg8::EpiIn E{P.Qb, P.Kb, P.Vb, P.Ub, P.rstd1, P.g_q, P.g_k};
          pg8::gemm_phase<pg8::EpiIn, pg8::StaticOrder, PG8_ALIGN, PG8_SP2>(F.lds, g, S, E); }
        { pg8::Gemm g{P.PB, P.Wpp_t, M, D, PLE}; pg8::StaticOrder S; const int n2 = (M / 256) * (INW / 256) - F.G;
            if (n2 > 0 && n2 < F.G && n2 % 8 == 0) S.init(M, D, F.G - n2, c >= n2 ? c - n2 : (1 << 24)); else S.init(M, D, F.G, c);
          pg8::EpiBf16 E{P.PE, D};
          pg8::gemm_phase<pg8::EpiBf16, pg8::StaticOrder, PG8_ALIGN, PG8_SP2>(F.lds, g, S, E); }
        if (BOTH(1)) GRID_BAR();
    }
    PH_END(1);

    PH_BEGIN(); if (IN(2)) {
        att::attn_phase((att::lds_ptr)F.lds, P.Qb, P.Kb, P.Vb, P.MIX, P.rel_bias, P.sinks, F.vcu, F.G);
        att::pool_phase(P.Ub, P.MIX, M, F.vcu * NWAVES + F.wave, F.G * NWAVES, F.lane);
        if (BOTH(2)) GRID_BAR();
    }
    PH_END(2);

    PH_BEGIN(); if (IN(3)) {
        pg8::Gemm g{P.MIX, P.Wout_t, M, D, D}; pg8::StaticOrder S; S.init(M, D, F.G, c);
        pg8::EpiRes E{P.AB, P.ssq2};
        pg8::gemm_phase<pg8::EpiRes, pg8::StaticOrder, PG8_ALIGN, PG8_SP2>(F.lds, g, S, E);
        if (BOTH(3)) GRID_BAR();
    }
    PH_END(3);

    PH_BEGIN(); if (IN(4)) {
        pg8::Gemm g{P.AB, P.Wgu_t, M, 2 * FF, D}; pg8::StaticOrder S; S.init(M, 2 * FF, F.G, c);
        pg8::EpiGU E{P.Fb, FF, P.ssq2};
        pg8::gemm_phase<pg8::EpiGU, pg8::StaticOrder, PG8_ALIGN, PG8_SP2>(F.lds, g, S, E);
        if (BOTH(4)) GRID_BAR();
    }
    PH_END(4);

    PH_BEGIN(); if (IN(5)) {
        pg8::Gemm g{P.Fb, P.Wdown_t, M, D, FF}; pg8::StaticOrder S; S.init(M, D, F.G, c);
        pg8::EpiRes E{P.AB, P.ssq3};
        pg8::gemm_phase<pg8::EpiRes, pg8::StaticOrder, PG8_ALIGN, PG8_SP2>(F.lds, g, S, E);
        if (BOTH(5)) GRID_BAR();
    }
    PH_END(5);

    PH_BEGIN(); if (IN(6)) {
        pg8::Gemm g{P.AB, P.Wpg_t, M, D, D}; pg8::StaticOrder S; S.init(M, D, F.G, c);
        pg8::EpiFinal E{P.out, P.AB, P.PE, P.ssq3};
        pg8::gemm_phase<pg8::EpiFinal, pg8::StaticOrder, PG8_ALIGN, PG8_SP2>(F.lds, g, S, E);
    }
    PH_END(6);
    if (PROBE_ABS >= 0 && blockIdx.x == 0 && F.tid == 0) P.out[0] += (float)ptabs_ * 0.01f * PROBE_SCALE;
#undef IN
#undef BOTH
#undef GRID_BAR
}

extern "C" void kernel_launch(void* const* d_in, const int* in_sizes, int n_in, void* d_out, int out_size, void* d_ws, size_t ws_size, hipStream_t stream) {
    static int grid = 0;
    if (grid == 0) {
        if (n_in != 18 || in_sizes[0] != M * D || out_size != M * D || ws_size < WS_END) { fprintf(stderr, "kernel_launch: unexpected shapes (n_in %d, in0 %d, out %d, ws %zu); nothing launched\n", n_in, n_in > 0 ? in_sizes[0] : -1, out_size, ws_size); grid = -1; return; }
        int dev = 0, cus = 0, per_cu = 0;
        if (hipGetDevice(&dev) != hipSuccess || hipDeviceGetAttribute(&cus, hipDeviceAttributeMultiprocessorCount, dev) != hipSuccess) { fprintf(stderr, "kernel_launch: device query failed\n"); grid = -1; return; }
        if (hipFuncSetAttribute((const void*)hymba_fwd, hipFuncAttributeMaxDynamicSharedMemorySize, LDS_BYTES) != hipSuccess) { fprintf(stderr, "kernel_launch: hipFuncSetAttribute failed\n"); grid = -1; return; }
        if (hipOccupancyMaxActiveBlocksPerMultiprocessor(&per_cu, (const void*)hymba_fwd, NWAVES * 64, LDS_BYTES) != hipSuccess || per_cu < 1) { fprintf(stderr, "kernel_launch: occupancy query reports %d workgroups per CU\n", per_cu); per_cu = 1; }
        (void)hipGetLastError();
        grid = cus;
    }
    if (grid < 0) return;
    if (N_LAUNCHES == 1) { if (hipMemsetAsync((char*)d_ws + WS_CTL, 0, CTL_ZERO_BYTES, stream) != hipSuccess) { fprintf(stderr, "kernel_launch: hipMemsetAsync failed\n"); return; } }
    Args a{};
    unsigned char* ws = (unsigned char*)d_ws;
    Ptrs& P = a.P;
    P.x = (const float*)d_in[0]; P.p = (const float*)d_in[1]; P.w_in = (const float*)d_in[2]; P.w_out = (const float*)d_in[3]; P.g_attn = (const float*)d_in[4]; P.g_q = (const float*)d_in[5];
    P.g_k = (const float*)d_in[6]; P.sinks = (const float*)d_in[7]; P.rel_bias = (const float*)d_in[8]; P.w_pool = (const float*)d_in[9]; P.pool_scale = (const float*)d_in[10];
    P.g_ffn = (const float*)d_in[11]; P.w_gate = (const float*)d_in[12]; P.w_up = (const float*)d_in[13]; P.w_down = (const float*)d_in[14]; P.g_ple = (const float*)d_in[15];
    P.w_pg = (const float*)d_in[16]; P.w_pp = (const float*)d_in[17]; P.out = (float*)d_out;
    P.Win_t = (bf16*)(ws + WS_WIN); P.Wpp_t = (bf16*)(ws + WS_WPP); P.Wout_t = (bf16*)(ws + WS_WOUT); P.Wgu_t = (bf16*)(ws + WS_WGU); P.Wdown_t = (bf16*)(ws + WS_WDN); P.Wpg_t = (bf16*)(ws + WS_WPG);
    P.AB = (bf16*)(ws + WS_AB); P.PB = (bf16*)(ws + WS_PB); P.Qb = (bf16*)(ws + WS_Q); P.Kb = (bf16*)(ws + WS_K); P.Vb = (bf16*)(ws + WS_V); P.Ub = (bf16*)(ws + WS_U);
    P.MIX = (bf16*)(ws + WS_MIX); P.PE = (bf16*)(ws + WS_PE); P.Fb = (bf16*)(ws + WS_F);
    P.rstd1 = (float*)(ws + WS_RSTD1); P.ssq2 = (float*)(ws + WS_SSQ2); P.ssq3 = (float*)(ws + WS_SSQ3);
    a.ws = ws;
    for (int li = 0; li < N_LAUNCHES; ++li) {
        a.ph_lo = (N_LAUNCHES == 1) ? 0 : li; a.ph_hi = (N_LAUNCHES == 1) ? N_PHASES : li + 1;
        hipLaunchKernelGGL(hymba_fwd, dim3(grid), dim3(NWAVES * 64), LDS_BYTES, stream, a);
        const hipError_t le = hipPeekAtLastError();
        if (le != hipSuccess) { fprintf(stderr, "kernel_launch: launch %d failed: %s\n", li, hipGetErrorName(le)); break; }
    }
}
```

```cpp
#include <hip/hip_runtime.h>
#include <hip/hip_bf16.h>
#include <cstdio>
#include <cstdint>
#include <cmath>
#ifndef PROBE_EPI
#define PROBE_EPI 0
#endif
namespace pg8 {
#define PG8_LAS __attribute__((address_space(3)))
typedef unsigned short bf16_t;
typedef short bf16x8 __attribute__((ext_vector_type(8)));
typedef float f32x4 __attribute__((ext_vector_type(4)));
typedef unsigned u32x4 __attribute__((ext_vector_type(4)));
constexpr int BM = 256, BK = 64, HALF = 128, HTB = HALF * BK * 2  , STAGE_BYTES = 8 * HTB, NXCD = 8, WGM = 8;

__host__ __device__ __forceinline__ int lds_byte(int r, int c) { const int st = (r >> 4) * 2 + (c >> 5), rr = r & 15, cc = c & 31, ob = rr * 64 + cc * 2; return st * 1024 + (ob ^ (((ob >> 9) & 1) << 5)); }
__host__ __device__ __forceinline__ void stage_rc(int b, int& R, int& C) { const int st = b / 1024, sb = b % 1024, swz = sb ^ (((sb >> 9) & 1) << 5); R = (st >> 1) * 16 + swz / 64; C = (st & 1) * 32 + (swz % 64) / 2; }
__host__ __device__ __forceinline__ int perm32(int rho) { const int n = rho >> 4, i = rho & 15; return 8 * (i >> 2) + 4 * n + (i & 3); }

struct Unit { int pm, pn; };
struct Gemm { const bf16_t* A; const bf16_t* Bt; int M, N, K; };

struct StaticOrder {
    int nM, nN, nwg, G, c;
    __host__ __device__ void init(int M, int N, int G_, int c_) { nM = M / BM; nN = N / BM; nwg = nM * nN; G = G_; c = c_; }
    __host__ __device__ bool next(int i, Unit& u) const {
        const long L = (long)i * G + c; if (L >= nwg) return false;
        int wgid = (int)L; { const int q = nwg / NXCD, r = nwg % NXCD, xcd = wgid % NXCD, off = wgid / NXCD; wgid = (xcd < r ? xcd * (q + 1) : r * (q + 1) + (xcd - r) * q) + off; }
        const int nig = WGM * nN, gid = wgid / nig, fm = gid * WGM, gsz = (nM - fm) < WGM ? (nM - fm) : WGM;
        u.pm = fm + ((wgid % nig) % gsz); u.pn = (wgid % nig) / gsz; return true;
    }
    __device__ __forceinline__ void a_ready(const Unit&) const {}
    __device__ __forceinline__ void done(const Unit&) const {}
};

__device__ __forceinline__ unsigned cvt_pk_bf16(float lo, float hi) { unsigned r; asm volatile("v_cvt_pk_bf16_f32 %0, %1, %2" : "=v"(r) : "v"(lo), "v"(hi)); return r; }
__device__ __forceinline__ u32x4 pack8(const f32x4 a, const f32x4 b) { u32x4 w; w.x = cvt_pk_bf16(a[0], a[1]); w.y = cvt_pk_bf16(a[2], a[3]); w.z = cvt_pk_bf16(b[0], b[1]); w.w = cvt_pk_bf16(b[2], b[3]); return w; }
__device__ __forceinline__ f32x4 bf_lo4(unsigned a, unsigned b) { return (f32x4){__uint_as_float(a << 16), __uint_as_float(a & 0xffff0000u), __uint_as_float(b << 16), __uint_as_float(b & 0xffff0000u)}; }
__device__ __forceinline__ float quad_sum(float s) { s += __shfl_xor(s, 16); s += __shfl_xor(s, 32); return s; }
constexpr float LOG2E = 1.4426950408889634f;
constexpr float QSCALE = 0.125f * LOG2E;
constexpr float NEPS = 1e-6f;

struct EpiBf16 {
    static constexpr bool PERM = true, AFTER_DRAIN = false;
    bf16_t* O; int ldc;
    __device__ __forceinline__ void operator()(const f32x4 (&acc)[2][2][4][2], const Unit& u, int wr, int wc, int fr, int fq) const {
        const int row0 = u.pm * BM + wr * 64 + fr, col0 = u.pn * BM + wc * 32 + 8 * fq;
#pragma unroll
        for (int ai = 0; ai < 2; ++ai)
#pragma unroll
            for (int m = 0; m < 4; ++m) { bf16_t* rowp = O + (size_t)(row0 + ai * HALF + m * 16) * ldc + col0;
#pragma unroll
                for (int bj = 0; bj < 2; ++bj) *(u32x4*)(rowp + bj * HALF) = pack8(acc[ai][bj][m][0], acc[ai][bj][m][1]); }
    }
};

struct EpiIn {
    static constexpr bool PERM = true, AFTER_DRAIN = false;
    bf16_t *Q, *Kb, *Vb, *U; const float* rstd; const float* gq; const float* gk;
    __device__ __forceinline__ void operator()(const f32x4 (&acc)[2][2][4][2], const Unit& u, int wr, int wc, int fr, int fq) const {
        const int pn = u.pn; const int row0 = u.pm * BM + wr * 64 + fr;
        const int mode = pn < 2 ? 0 : (pn == 2 ? (wc < 2 ? 1 : 2) : 2);
        bf16_t* base; int ldc, colb;
        if (pn < 2) { base = Q; ldc = 512; colb = 256 * pn + 64 * wc; }
        else if (pn == 2) { if (wc < 2) { base = Kb; colb = 64 * wc; } else { base = Vb; colb = 64 * (wc - 2); } ldc = 128; }
        else { base = U; ldc = 512; colb = 256 * (pn - 3) + 64 * wc; }
        f32x4 gv[2][2];
#pragma unroll
        for (int bj = 0; bj < 2; ++bj)
#pragma unroll
            for (int n = 0; n < 2; ++n) {
                gv[bj][n] = (f32x4){1.f, 1.f, 1.f, 1.f};
                if (mode == 0) gv[bj][n] = *(const f32x4*)(gq + 32 * bj + 8 * fq + 4 * n) * QSCALE;
                if (mode == 1) gv[bj][n] = *(const f32x4*)(gk + 32 * bj + 8 * fq + 4 * n);
            }
#pragma unroll
        for (int ai = 0; ai < 2; ++ai)
#pragma unroll
            for (int m = 0; m < 4; ++m) {
                const int row = row0 + ai * HALF + m * 16; const float rs = rstd[row];
                f32x4 v[2][2]; float ss = 0.f;
#pragma unroll
                for (int bj = 0; bj < 2; ++bj)
#pragma unroll
                    for (int n = 0; n < 2; ++n) { v[bj][n] = acc[ai][bj][m][n] * rs; const f32x4 q = v[bj][n] * v[bj][n]; ss += (q[0] + q[1]) + (q[2] + q[3]); }
                if (mode < 2) { ss = quad_sum(ss); const float hr = __builtin_amdgcn_rsqf(ss * (1.f / 64.f) + NEPS);
#pragma unroll
                    for (int bj = 0; bj < 2; ++bj)
#pragma unroll
                        for (int n = 0; n < 2; ++n) v[bj][n] = v[bj][n] * hr * gv[bj][n]; }
                bf16_t* rowp = base + (size_t)row * ldc + colb + 8 * fq;
#pragma unroll
                for (int bj = 0; bj < 2; ++bj) *(u32x4*)(rowp + 32 * bj) = pack8(v[bj][0], v[bj][1]);
            }
    }
};

struct EpiRes {
    static constexpr bool PERM = true, AFTER_DRAIN = false;
    bf16_t* hb; float* ssq;
    __device__ __forceinline__ void operator()(const f32x4 (&acc)[2][2][4][2], const Unit& u, int wr, int wc, int fr, int fq) const {
        const int row0 = u.pm * BM + wr * 64 + fr, col0 = u.pn * BM + wc * 32 + 8 * fq;
#pragma unroll
        for (int ai = 0; ai < 2; ++ai)
#pragma unroll
            for (int m = 0; m < 4; ++m) {
                const int row = row0 + ai * HALF + m * 16; const size_t off = (size_t)row * 1024 + col0; float ss = 0.f;
#pragma unroll
                for (int bj = 0; bj < 2; ++bj) {
                    const u32x4 w = *(const u32x4*)(hb + off + bj * HALF);
                    const f32x4 h0 = bf_lo4(w.x, w.y) + acc[ai][bj][m][0], h1 = bf_lo4(w.z, w.w) + acc[ai][bj][m][1];
                    *(u32x4*)(hb + off + bj * HALF) = pack8(h0, h1);
                    const f32x4 q0 = h0 * h0, q1 = h1 * h1; ss += ((q0[0] + q0[1]) + (q0[2] + q0[3])) + ((q1[0] + q1[1]) + (q1[2] + q1[3]));
                }
                ss = quad_sum(ss);
                if (fq == 0) ssq[(size_t)row * 16 + 4 * u.pn + wc] = ss;
            }
    }
};

__device__ __forceinline__ float row_rstd(const float* ssq, int row, int fq) {
    const f32x4 p = *(const f32x4*)(ssq + (size_t)row * 16 + 4 * fq);
    const float t = quad_sum((p[0] + p[1]) + (p[2] + p[3]));
    return __builtin_amdgcn_rsqf(t * (1.f / 1024.f) + NEPS);
}

struct EpiGU {
    static constexpr bool PERM = true, AFTER_DRAIN = false;
    bf16_t* F; int ldc; const float* ssq;
    __device__ __forceinline__ void operator()(const f32x4 (&acc)[2][2][4][2], const Unit& u, int wr, int wc, int fr, int fq) const {
        const int row0 = u.pm * BM + wr * 64 + fr, col0 = u.pn * HALF + wc * 32 + 8 * fq;
#pragma unroll
        for (int ai = 0; ai < 2; ++ai)
#pragma unroll
            for (int m = 0; m < 4; ++m) {
                const int row = row0 + ai * HALF + m * 16; const float rs = row_rstd(ssq, row, fq);
                f32x4 f[2];
#pragma unroll
                for (int n = 0; n < 2; ++n) {
                    const f32x4 g = acc[ai][0][m][n] * rs, up = acc[ai][1][m][n] * rs;
#pragma unroll
                    for (int j = 0; j < 4; ++j) f[n][j] = g[j] * __builtin_amdgcn_rcpf(1.f + __builtin_amdgcn_exp2f(-LOG2E * g[j])) * up[j];
                }
                *(u32x4*)(F + (size_t)row * ldc + col0) = pack8(f[0], f[1]);
            }
    }
};

struct EpiFinal {
    static constexpr bool PERM = true, AFTER_DRAIN = false;
    float* out; const bf16_t* hb; const bf16_t* pe; const float* ssq;
    __device__ __forceinline__ void operator()(const f32x4 (&acc)[2][2][4][2], const Unit& u, int wr, int wc, int fr, int fq) const {
        const int row0 = u.pm * BM + wr * 64 + fr, col0 = u.pn * BM + wc * 32 + 8 * fq;
#pragma unroll
        for (int ai = 0; ai < 2; ++ai)
#pragma unroll
            for (int m = 0; m < 4; ++m) {
                const int row = row0 + ai * HALF + m * 16; const size_t off = (size_t)row * 1024 + col0; const float rs = row_rstd(ssq, row, fq);
#pragma unroll
                for (int bj = 0; bj < 2; ++bj) {
                    const u32x4 pw = *(const u32x4*)(pe + off + bj * HALF), hw = *(const u32x4*)(hb + off + bj * HALF);
                    const f32x4 p0 = bf_lo4(pw.x, pw.y), p1 = bf_lo4(pw.z, pw.w);
                    f32x4 h0 = bf_lo4(hw.x, hw.y), h1 = bf_lo4(hw.z, hw.w);
                    const f32x4 a0 = acc[ai][bj][m][0] * rs, a1 = acc[ai][bj][m][1] * rs;
#pragma unroll
                    for (int j = 0; j < 4; ++j) { h0[j] += p0[j] * __builtin_amdgcn_rcpf(1.f + __builtin_amdgcn_exp2f(-LOG2E * a0[j])); h1[j] += p1[j] * __builtin_amdgcn_rcpf(1.f + __builtin_amdgcn_exp2f(-LOG2E * a1[j])); }
                    *(f32x4*)(out + off + bj * HALF) = h0; *(f32x4*)(out + off + bj * HALF + 4) = h1;
                }
                if (m & 1) asm volatile("" ::: "memory");
            }
    }
};

template <class Epi, class Sched, bool ALIGN_EPI = false, bool SP2 = false>
__device__ __forceinline__ void gemm_phase(PG8_LAS unsigned char* lds, const Gemm g, const Sched& S, const Epi& E, unsigned long long& tepi) {
    const int tid = threadIdx.x, wid = __builtin_amdgcn_readfirstlane(tid >> 6), lane = tid & 63, wr = wid >> 2, wc = wid & 3, fr = lane & 15, fq = lane >> 4;
    const int K = g.K, nt = K / BK;
    unsigned voffA[2], voffB[2];
#pragma unroll
    for (int i = 0; i < 2; ++i) { int R, C; stage_rc(tid * 16 + i * 8192, R, C); const int Rb = Epi::PERM ? ((R & ~31) + perm32(R & 31)) : R;
        voffA[i] = (unsigned)(R * K + C) * 2u; voffB[i] = (unsigned)(Rb * K + C) * 2u; }
    const size_t kstep = (size_t)(BK * 2);
    const size_t hstep = (size_t)HALF * K * 2;
    const size_t tstep = 2 * hstep;
    const unsigned ldsw = (unsigned)wid * 1024u;
    const int aoff = lds_byte(wr * 64 + fr, fq * 8), boff = lds_byte(wc * 32 + fr, fq * 8);
#define PG8_SA(b, h) (((b) * 2 + (h)) * HTB)
#define PG8_SB(b, h) ((4 + (b) * 2 + (h)) * HTB)
#define PG8_STAGE(bufoff, gbase, voff) do { _Pragma("unroll") for (int _i = 0; _i < 2; ++_i) \
        __builtin_amdgcn_global_load_lds((const unsigned*)((const char*)(gbase) + (voff)[_i]), (PG8_LAS unsigned*)(lds + (bufoff) + ldsw + _i * 8192), 16, 0, 0); } while (0)
#define PG8_LDA(dst, b, h) do { _Pragma("unroll") for (int m = 0; m < 4; ++m) _Pragma("unroll") for (int k = 0; k < 2; ++k) dst[m][k] = *(const PG8_LAS bf16x8*)(lds + PG8_SA(b, h) + aoff + m * 2048 + k * 1024); } while (0)
#define PG8_LDB(dst, b, h) do { _Pragma("unroll") for (int n = 0; n < 2; ++n) _Pragma("unroll") for (int k = 0; k < 2; ++k) dst[n][k] = *(const PG8_LAS bf16x8*)(lds + PG8_SB(b, h) + boff + n * 2048 + k * 1024); } while (0)
#define PG8_MMA(ai, bj, At, Bt) do { __builtin_amdgcn_s_setprio(1); _Pragma("unroll") for (int m = 0; m < 4; ++m) _Pragma("unroll") for (int n = 0; n < 2; ++n) _Pragma("unroll") for (int k = 0; k < 2; ++k) \
        acc[ai][bj][m][n] = __builtin_amdgcn_mfma_f32_16x16x32_bf16(Bt[n][k], At[m][k], acc[ai][bj][m][n], 0, 0, 0); __builtin_amdgcn_s_setprio(0); } while (0)
#define PG8_WAIT_V(n) asm volatile("s_waitcnt vmcnt(" #n ")" ::: "memory")
#define PG8_WAIT_L(n) asm volatile("s_waitcnt lgkmcnt(" #n ")" ::: "memory")
#define PG8_BAR __builtin_amdgcn_s_barrier()
#define PG8_SCHED __builtin_amdgcn_sched_barrier(0)
    Unit cur, nxt; int ui = 0;
    if (!S.next(0, cur)) return;
    f32x4 acc[2][2][4][2];
#pragma unroll
    for (int a = 0; a < 2; ++a)
#pragma unroll
        for (int b = 0; b < 2; ++b)
#pragma unroll
            for (int m = 0; m < 4; ++m)
#pragma unroll
                for (int n = 0; n < 2; ++n) acc[a][b][m][n] = (f32x4){0.f, 0.f, 0.f, 0.f};
    bf16x8 At[4][2], B0[2][2], B1[2][2];
    const char* cA = (const char*)g.A + (size_t)cur.pm * tstep; const char* cB = (const char*)g.Bt + (size_t)cur.pn * tstep;
    S.a_ready(cur);
    if constexpr (SP2) {
        PG8_STAGE(PG8_SB(0, 0), cB, voffB); PG8_STAGE(PG8_SB(0, 1), cB + hstep, voffB); PG8_STAGE(PG8_SA(0, 0), cA, voffA); PG8_STAGE(PG8_SA(0, 1), cA + hstep, voffA);
        if (wr == 1) PG8_BAR;
        PG8_WAIT_V(2); PG8_BAR;
        PG8_STAGE(PG8_SB(1, 0), cB + kstep, voffB); PG8_STAGE(PG8_SA(1, 0), cA + kstep, voffA); PG8_STAGE(PG8_SB(1, 1), cB + hstep + kstep, voffB);
        PG8_WAIT_V(6); PG8_BAR;
    } else {
        PG8_STAGE(PG8_SB(0, 0), cB, voffB); PG8_STAGE(PG8_SA(0, 0), cA, voffA); PG8_STAGE(PG8_SB(0, 1), cB + hstep, voffB); PG8_STAGE(PG8_SA(0, 1), cA + hstep, voffA);
        if (wr == 1) PG8_BAR;
        PG8_WAIT_V(4); PG8_BAR;
        PG8_STAGE(PG8_SB(1, 0), cB + kstep, voffB); PG8_STAGE(PG8_SA(1, 0), cA + kstep, voffA); PG8_STAGE(PG8_SB(1, 1), cB + hstep + kstep, voffB);
        PG8_WAIT_V(6); PG8_BAR;
    }
    for (;;) {
        const bool has_next = S.next(ui + 1, nxt);
        const char* nA = has_next ? (const char*)g.A + (size_t)nxt.pm * tstep : cA; const char* nB = has_next ? (const char*)g.Bt + (size_t)nxt.pn * tstep : cB;
        for (int t = 0; t < nt; t += 2) {
            const bool last = (t == nt - 2);
            const char* a1 = cA + (size_t)(t + 1) * kstep;
            const char* a2 = last ? nA : cA + (size_t)(t + 2) * kstep; const char* b2 = last ? nB : cB + (size_t)(t + 2) * kstep;
            const char* a3 = a2 + kstep; const char* b3 = b2 + kstep;
            if (last && has_next) S.a_ready(nxt);
            if constexpr (SP2) {
            PG8_LDB(B0, 0, 0); PG8_LDB(B1, 0, 1); PG8_SCHED; PG8_LDA(At, 0, 0); PG8_STAGE(PG8_SA(1, 1), a1 + hstep, voffA);
            PG8_WAIT_V(8); PG8_WAIT_L(0); PG8_BAR; PG8_MMA(0, 0, At, B0); PG8_MMA(0, 1, At, B1); PG8_BAR; PG8_SCHED;
            PG8_LDA(At, 0, 1); PG8_STAGE(PG8_SB(0, 0), b2, voffB); PG8_STAGE(PG8_SB(0, 1), b2 + hstep, voffB); PG8_STAGE(PG8_SA(0, 0), a2, voffA);
            PG8_WAIT_V(8); PG8_WAIT_L(0); PG8_BAR; PG8_MMA(1, 0, At, B0); PG8_MMA(1, 1, At, B1); PG8_BAR; PG8_SCHED;
            PG8_LDB(B0, 1, 0); PG8_LDB(B1, 1, 1); PG8_SCHED; PG8_LDA(At, 1, 0); PG8_STAGE(PG8_SA(0, 1), a2 + hstep, voffA);
            PG8_WAIT_V(8); PG8_WAIT_L(0); PG8_BAR; PG8_MMA(0, 0, At, B0); PG8_MMA(0, 1, At, B1); PG8_BAR; PG8_SCHED;
            PG8_LDA(At, 1, 1); PG8_STAGE(PG8_SB(1, 0), b3, voffB); PG8_STAGE(PG8_SB(1, 1), b3 + hstep, voffB); PG8_STAGE(PG8_SA(1, 0), a3, voffA);
            PG8_WAIT_V(8); PG8_WAIT_L(0); PG8_BAR; PG8_MMA(1, 0, At, B0); PG8_MMA(1, 1, At, B1); PG8_BAR; PG8_SCHED;
            } else {
            PG8_LDB(B0, 0, 0); PG8_SCHED; PG8_LDA(At, 0, 0); PG8_STAGE(PG8_SA(1, 1), a1 + hstep, voffA);
            PG8_WAIT_L(8); PG8_BAR; PG8_WAIT_L(0); PG8_MMA(0, 0, At, B0); PG8_BAR; PG8_SCHED;
            PG8_LDB(B1, 0, 1); PG8_STAGE(PG8_SB(0, 0), b2, voffB);
            PG8_BAR; PG8_WAIT_L(0); PG8_MMA(0, 1, At, B1); PG8_BAR;
            PG8_LDA(At, 0, 1); PG8_STAGE(PG8_SA(0, 0), a2, voffA);
            PG8_BAR; PG8_WAIT_L(0); PG8_MMA(1, 0, At, B0); PG8_BAR; PG8_SCHED;
            PG8_STAGE(PG8_SB(0, 1), b2 + hstep, voffB);
            PG8_WAIT_V(6); PG8_BAR; PG8_MMA(1, 1, At, B1); PG8_BAR;
            PG8_LDB(B0, 1, 0); PG8_SCHED; PG8_LDA(At, 1, 0); PG8_STAGE(PG8_SA(0, 1), a2 + hstep, voffA);
            PG8_WAIT_L(8); PG8_BAR; PG8_WAIT_L(0); PG8_MMA(0, 0, At, B0); PG8_BAR; PG8_SCHED;
            PG8_LDB(B1, 1, 1); PG8_STAGE(PG8_SB(1, 0), b3, voffB);
            PG8_BAR; PG8_WAIT_L(0); PG8_MMA(0, 1, At, B1); PG8_BAR;
            PG8_LDA(At, 1, 1); PG8_STAGE(PG8_SA(1, 0), a3, voffA);
            PG8_BAR; PG8_WAIT_L(0); PG8_MMA(1, 0, At, B0); PG8_BAR; PG8_SCHED;
            PG8_STAGE(PG8_SB(1, 1), b3 + hstep, voffB);
            PG8_WAIT_V(6); PG8_BAR; PG8_MMA(1, 1, At, B1); PG8_BAR;
            }
        }
        if constexpr (ALIGN_EPI) { if (wr == 0) PG8_BAR; }
        if constexpr (!Epi::AFTER_DRAIN) {
#if PROBE_EPI
            const unsigned long long te0_ = __builtin_amdgcn_s_memrealtime();
#endif
            E(acc, cur, wr, wc, fr, fq); S.done(cur);
#if PROBE_EPI
            tepi += __builtin_amdgcn_s_memrealtime() - te0_;
#endif
        }
        if (!has_next) break;
#pragma unroll
        for (int a = 0; a < 2; ++a)
#pragma unroll
            for (int b = 0; b < 2; ++b)
#pragma unroll
                for (int m = 0; m < 4; ++m)
#pragma unroll
                    for (int n = 0; n < 2; ++n) acc[a][b][m][n] = (f32x4){0.f, 0.f, 0.f, 0.f};
        cur = nxt; cA = nA; cB = nB; ++ui;
        if constexpr (ALIGN_EPI) { if (wr == 1) PG8_BAR; }
    }
    PG8_WAIT_V(0);
    if constexpr (!ALIGN_EPI) { if (wr == 0) PG8_BAR; }
    PG8_BAR;
    if constexpr (Epi::AFTER_DRAIN) { E.fused(acc, cur, wr, wc, fr, fq, lds, wid, lane); S.done(cur); }
#undef PG8_SA
#undef PG8_SB
#undef PG8_STAGE
#undef PG8_LDA
#undef PG8_LDB
#undef PG8_MMA
#undef PG8_WAIT_V
#undef PG8_WAIT_L
#undef PG8_BAR
#undef PG8_SCHED
}
}

#ifndef PG8_SP2
#define PG8_SP2 true
#endif
#ifndef PG8_ALIGN
#define PG8_ALIGN true
#endif

namespace att {
using bf16 = unsigned short;
using bf16x8 = __attribute__((ext_vector_type(8))) short;
using s16x4 = __attribute__((ext_vector_type(4))) short;
using f32x16 = __attribute__((ext_vector_type(16))) float;
using u32x4 = __attribute__((ext_vector_type(4))) unsigned;
typedef __attribute__((address_space(3))) const char* lds_cptr;
typedef __attribute__((address_space(3))) char* lds_ptr;
typedef short v4i16_t __attribute__((ext_vector_type(4)));
constexpr int SEQ = 4096, NITEMS = 4 * 2 * (SEQ / 64);
constexpr int KVP = 128;
constexpr int BUFB = 49152;
constexpr int OST_OFF = 2 * BUFB;
constexpr int WSF_OFF = OST_OFF + 32768;
constexpr int BT_OFF = 135168;
constexpr int BT_LEN = 260, BT_PAD = 68;
__device__ __forceinline__ int crow(int r, int hi) { return (r & 3) + 8 * (r >> 2) + 4 * hi; }
__device__ __forceinline__ void glds16(const void* gsrc, unsigned lds_dst) { unsigned keep;
    asm volatile("s_mov_b32 %0, m0\n\ts_mov_b32 m0, %2\n\ts_nop 0\n\tglobal_load_lds_dwordx4 %1, off\n\ts_mov_b32 m0, %0" : "=&s"(keep) : "v"(gsrc), "s"(lds_dst) : "memory"); }
__device__ __forceinline__ s16x4 vtr(lds_cptr p) { return __builtin_bit_cast(s16x4, __builtin_amdgcn_ds_read_tr16_b64_v4i16((__attribute__((address_space(3))) v4i16_t*)p)); }
typedef float f32x2_t __attribute__((ext_vector_type(2))); typedef __bf16 bf16x2_t __attribute__((ext_vector_type(2)));
__device__ __forceinline__ unsigned cvtpk_s(float lo, float hi) { f32x2_t v = {lo, hi}; bf16x2_t b = __builtin_convertvector(v, bf16x2_t); return __builtin_bit_cast(unsigned, b); }
__device__ __forceinline__ int t5_bucket(int d) { if (d < 16) return d; const int b = 16 + (int)(log2f((float)d * 0.0625f) * (16.0f / 3.0f)); return b < 31 ? b : 31; }

__device__ __forceinline__ void qkt(f32x16& p0, f32x16& p1, lds_cptr Kslot, const bf16x8* qr, int r32, int hi) {
    const lds_cptr kb = Kslot + hi * 1024 + r32 * 16;
    const f32x16 z = {0.f, 0.f, 0.f, 0.f, 0.f, 0.f, 0.f, 0.f, 0.f, 0.f, 0.f, 0.f, 0.f, 0.f, 0.f, 0.f};
#pragma unroll
    for (int d0 = 0; d0 < 4; ++d0) {
        const bf16x8 b0 = *(const __attribute__((address_space(3))) bf16x8*)(kb + d0 * 2048);
        const bf16x8 b1 = *(const __attribute__((address_space(3))) bf16x8*)(kb + d0 * 2048 + 512);
        if (d0 == 0) { p0 = __builtin_amdgcn_mfma_f32_32x32x16_bf16(b0, qr[0], z, 0, 0, 0); p1 = __builtin_amdgcn_mfma_f32_32x32x16_bf16(b1, qr[0], z, 0, 0, 0); }
        else { p0 = __builtin_amdgcn_mfma_f32_32x32x16_bf16(b0, qr[d0], p0, 0, 0, 0); p1 = __builtin_amdgcn_mfma_f32_32x32x16_bf16(b1, qr[d0], p1, 0, 0, 0); }
    }
}
__device__ __forceinline__ void pv(f32x16* o, lds_cptr vp, const u32x4 (&pw)[4]) {
#pragma unroll
    for (int d0 = 0; d0 < 2; ++d0) {
#pragma unroll
        for (int ks = 0; ks < 4; ++ks) {
            const s16x4 lo = vtr(vp + d0 * 4096 + ks * 1024), hi = vtr(vp + d0 * 4096 + ks * 1024 + 512);
            const bf16x8 vf = (bf16x8){lo[0], lo[1], lo[2], lo[3], hi[0], hi[1], hi[2], hi[3]};
            o[d0] = __builtin_amdgcn_mfma_f32_32x32x16_bf16(__builtin_bit_cast(bf16x8, pw[ks]), vf, o[d0], 0, 0, 0);
        }
    }
}
#define ATT_WAIT_BAR() asm volatile("s_waitcnt vmcnt(0) lgkmcnt(0)\n\ts_barrier" ::: "memory")

__device__ __forceinline__ void attn_phase(lds_ptr lds, const bf16* Q, const bf16* K, const bf16* V, bf16* MIX, const float* rel_bias, const float* sinks, int vcu, int G) {
    const int tid = threadIdx.x, lane = tid & 63, r32 = lane & 31, hi = lane >> 5; const int wid = __builtin_amdgcn_readfirstlane(tid >> 6);
    const unsigned lds0 = (unsigned)(uintptr_t)lds;
    { __attribute__((address_space(3))) float* bt = (__attribute__((address_space(3))) float*)(lds + BT_OFF);
      for (int i = tid; i < 8 * BT_LEN; i += 512) { const int h = i / BT_LEN, d = i % BT_LEN - BT_PAD;
          bt[i] = (d >= 0 && d < 128) ? rel_bias[t5_bucket(d) * 8 + h] * 1.4426950408889634f : -INFINITY; } }
    const int hw = wid >> 1, half = wid & 1;
#define ATT_DECODE(it, b_, kvh_, q0_) const int b_ = (it) >> 7, kvh_ = ((it) >> 6) & 1, q0_ = ((it) & 63) * 64
#define ATT_ISSUE(it, bufoff) do { ATT_DECODE(it, b_, kvh_, q0_); const bf16* Kh_ = K + (size_t)b_ * SEQ * KVP + kvh_ * 64; const bf16* Vh_ = V + (size_t)b_ * SEQ * KVP + kvh_ * 64; \
        _Pragma("unroll") for (int j_ = 0; j_ < 3; ++j_) { int pk_ = q0_ - 128 + 64 * j_ + lane; pk_ = pk_ < 0 ? 0 : pk_; \
            glds16(Kh_ + (size_t)pk_ * KVP + wid * 8, (unsigned)__builtin_amdgcn_readfirstlane(lds0 + (bufoff) + j_ * 8192 + wid * 1024)); \
            int pv_ = q0_ - 128 + 64 * j_ + 16 * (wid & 3) + (lane >> 2); pv_ = pv_ < 0 ? 0 : pv_; \
            glds16(Vh_ + (size_t)pv_ * KVP + (wid >> 2) * 32 + (lane & 3) * 8, (unsigned)__builtin_amdgcn_readfirstlane(lds0 + (bufoff) + 24576 + j_ * 8192 + wid * 1024)); } } while (0)
    int it = vcu; int bufoff = 0;
    if (it < NITEMS) ATT_ISSUE(it, 0);
    for (; it < NITEMS; it += G, bufoff ^= BUFB) {
        ATT_DECODE(it, b, kvh, q0);
        const int h = 4 * kvh + hw;
        const size_t rowq = (size_t)b * SEQ + q0 + 32 * half;
        bf16x8 qr[4];
#pragma unroll
        for (int d0 = 0; d0 < 4; ++d0) qr[d0] = *(const bf16x8*)(Q + (rowq + r32) * 512 + h * 64 + d0 * 16 + hi * 8);
        ATT_WAIT_BAR();
        if (it + G < NITEMS) ATT_ISSUE(it + G, bufoff ^ BUFB);
        const lds_cptr kv = (lds_cptr)lds + bufoff;
        f32x16 p[3][2];
#pragma unroll
        for (int j = 0; j < 3; ++j) qkt(p[j][0], p[j][1], kv + j * 8192, qr, r32, hi);
        const __attribute__((address_space(3))) float* bt = (const __attribute__((address_space(3))) float*)(lds + BT_OFF) + h * BT_LEN + BT_PAD + 128 + 32 * half + r32 - 4 * hi;
#pragma unroll
        for (int j = 0; j < 3; ++j)
#pragma unroll
            for (int hf = 0; hf < 2; ++hf)
#pragma unroll
                for (int r = 0; r < 16; ++r) { const int cst = 64 * j + 32 * hf + (r & 3) + 8 * (r >> 2); p[j][hf][r] += bt[-cst]; }
        if (q0 < 128) {
#pragma unroll
            for (int j = 0; j < 2; ++j)
#pragma unroll
                for (int hf = 0; hf < 2; ++hf)
#pragma unroll
                    for (int r = 0; r < 16; ++r) { const int kk = 64 * j + 32 * hf + crow(r, hi); if (q0 - 128 + kk < 0) p[j][hf][r] = -INFINITY; }
        }
        const float sink2 = sinks[h] * 1.4426950408889634f;
        float mx = sink2;
#pragma unroll
        for (int j = 0; j < 3; ++j)
#pragma unroll
            for (int hf = 0; hf < 2; ++hf)
#pragma unroll
                for (int r = 0; r < 16; ++r) mx = fmaxf(mx, p[j][hf][r]);
        { auto rr = __builtin_amdgcn_permlane32_swap(__float_as_uint(mx), __float_as_uint(mx), false, false); mx = fmaxf(__uint_as_float(rr[0]), __uint_as_float(rr[1])); }
        float l = 0.f;
#pragma unroll
        for (int j = 0; j < 3; ++j)
#pragma unroll
            for (int hf = 0; hf < 2; ++hf)
#pragma unroll
                for (int r = 0; r < 16; ++r) { const float e = __builtin_amdgcn_exp2f(p[j][hf][r] - mx); p[j][hf][r] = e; l += e; }
        { auto rr = __builtin_amdgcn_permlane32_swap(__float_as_uint(l), __float_as_uint(l), false, false); l = __uint_as_float(rr[0]) + __uint_as_float(rr[1]); }
        l += __builtin_amdgcn_exp2f(sink2 - mx);
        f32x16 o[2]; o[0] = f32x16{}; o[1] = f32x16{};
        const lds_cptr vp0 = kv + 24576 + ((lane >> 4) & 1) * 32 + (lane & 3) * 8 + (4 * hi + ((lane & 15) >> 2)) * 64;
#pragma unroll
        for (int j = 0; j < 3; ++j) {
            u32x4 pw[4];
#pragma unroll
            for (int ks = 0; ks < 4; ++ks) { const int hf = ks >> 1, b8 = (ks & 1) * 8;
                pw[ks] = (u32x4){cvtpk_s(p[j][hf][b8 + 0], p[j][hf][b8 + 1]), cvtpk_s(p[j][hf][b8 + 2], p[j][hf][b8 + 3]), cvtpk_s(p[j][hf][b8 + 4], p[j][hf][b8 + 5]), cvtpk_s(p[j][hf][b8 + 6], p[j][hf][b8 + 7])}; }
            pv(o, vp0 + j * 8192, pw);
        }
        __attribute__((address_space(3))) float* wsf = (__attribute__((address_space(3))) float*)(lds + WSF_OFF) + wid * 64;
        if (hi == 0) wsf[r32] = l;
        asm volatile("s_waitcnt lgkmcnt(0)" ::: "memory");
        float rli[16];
#pragma unroll
        for (int r = 0; r < 16; ++r) rli[r] = __builtin_amdgcn_rcpf(wsf[crow(r, hi)]);
        __attribute__((address_space(3))) bf16* stg = (__attribute__((address_space(3))) bf16*)(lds + OST_OFF) + wid * 2048;
#pragma unroll
        for (int r = 0; r < 16; ++r) { const int orow = crow(r, hi);
#pragma unroll
            for (int d0 = 0; d0 < 2; ++d0) stg[orow * 64 + d0 * 32 + r32] = (bf16)(cvtpk_s(o[d0][r] * rli[r], 0.f) & 0xffffu); }
        asm volatile("s_waitcnt lgkmcnt(0)" ::: "memory");
        bf16* Ow = MIX + rowq * 1024 + h * 64;
#pragma unroll
        for (int i = 0; i < 4; ++i) { const int row = i * 8 + (lane >> 3), ch = lane & 7; const u32x4 v = *(const __attribute__((address_space(3))) u32x4*)(stg + row * 64 + ch * 8); *(u32x4*)(Ow + (size_t)row * 1024 + ch * 8) = v; }
        asm volatile("s_waitcnt lgkmcnt(0)" ::: "memory");
    }
    ATT_WAIT_BAR();
#undef ATT_DECODE
#undef ATT_ISSUE
}

template <int W> __device__ __forceinline__ void pool_item(const bf16* U, bf16* MIX, int t, int oc) {
    const int tpos = t & (SEQ - 1);
    float s[8] = {0.f, 0.f, 0.f, 0.f, 0.f, 0.f, 0.f, 0.f}; float u0[8];
#pragma unroll
    for (int i = 0; i < W; ++i) {
        const bool ok = tpos - i >= 0; const int ti = ok ? t - i : t;
        const u32x4 w = *(const u32x4*)(U + (size_t)ti * 512 + oc * 8);
        const float v[8] = {__uint_as_float(w.x << 16), __uint_as_float(w.x & 0xffff0000u), __uint_as_float(w.y << 16), __uint_as_float(w.y & 0xffff0000u),
                            __uint_as_float(w.z << 16), __uint_as_float(w.z & 0xffff0000u), __uint_as_float(w.w << 16), __uint_as_float(w.w & 0xffff0000u)};
#pragma unroll
        for (int e = 0; e < 8; ++e) { if (i == 0) u0[e] = v[e]; s[e] += ok ? v[e] : 0.f; }
    }
    const float inv = 1.f / (float)(tpos + 1 < W ? tpos + 1 : W);
    u32x4 o; o.x = cvtpk_s(s[0] * inv - u0[0], s[1] * inv - u0[1]); o.y = cvtpk_s(s[2] * inv - u0[2], s[3] * inv - u0[3]);
    o.z = cvtpk_s(s[4] * inv - u0[4], s[5] * inv - u0[5]); o.w = cvtpk_s(s[6] * inv - u0[6], s[7] * inv - u0[7]);
    *(u32x4*)(MIX + (size_t)t * 1024 + 512 + oc * 8) = o;
}
__device__ __forceinline__ void pool_phase(const bf16* U, bf16* MIX, int Mrows, int gw, int NGW, int lane) {
    const int nitems = (Mrows / 4) * 4;
    for (int wi = gw; wi < nitems; wi += NGW) {
        const int g = wi & 3, t = (wi >> 2) * 4 + (lane >> 4), oc = g * 16 + (lane & 15);
        if (g == 0) pool_item<2>(U, MIX, t, oc); else if (g == 1) pool_item<4>(U, MIX, t, oc); else if (g == 2) pool_item<8>(U, MIX, t, oc); else pool_item<16>(U, MIX, t, oc);
    }
}
#undef ATT_WAIT_BAR
}

constexpr int NWAVES = 8;
#define GAS __attribute__((address_space(1)))
#define LAS __attribute__((address_space(3)))
typedef unsigned short bf16;
typedef unsigned v4u __attribute__((ext_vector_type(4)));
typedef float f32x4 __attribute__((ext_vector_type(4)));
typedef short bf16x8 __attribute__((ext_vector_type(8)));
typedef GAS unsigned gu32;
typedef GAS unsigned long long gu64;
#define RLX_AGENT __ATOMIC_RELAXED, __HIP_MEMORY_SCOPE_AGENT
#define LDS_WAIT() asm volatile("s_waitcnt lgkmcnt(0)" ::: "memory")
#define VM_WAIT() asm volatile("s_waitcnt vmcnt(0)" ::: "memory")
__device__ __forceinline__ unsigned long long rt() { return __builtin_amdgcn_s_memrealtime(); }
__device__ __forceinline__ unsigned f2bf(float f) { unsigned u = __builtin_bit_cast(unsigned, f); return (u + 0x7fffu + ((u >> 16) & 1u)) >> 16; }
__device__ __forceinline__ unsigned pk2(float lo, float hi) { return f2bf(lo) | (f2bf(hi) << 16); }

#define XB_TMO      128
#define XB_XCNT(j)  (256  + 64 * (j))
#define XB_XSUB(j)  (1280 + 64 * (j))
#define XB_XGEN(j)  (2304 + 64 * (j))
#define XB_TOP      3328
#define XB_TOPGEN   3392
#define XCD_BAR_WORDS 3456
#define XB_SPIN_CAP (1u << 18)

__device__ __forceinline__ unsigned xb_ld(unsigned* p)              { return __hip_atomic_load(p, __ATOMIC_RELAXED, __HIP_MEMORY_SCOPE_AGENT); }
__device__ __forceinline__ unsigned xb_add(unsigned* p, unsigned v) { return __hip_atomic_fetch_add(p, v, __ATOMIC_RELAXED, __HIP_MEMORY_SCOPE_AGENT); }
__device__ __forceinline__ unsigned xb_xcc_id() { return (unsigned)__builtin_amdgcn_s_getreg((3 << 11) | 20) & 0xFu; }
#define XB_SPIN(cond, bar) do { unsigned _sp = 0; while (cond) { __builtin_amdgcn_s_sleep(1); \
    if ((++_sp & 255u) == 0u) { if (xb_ld(&(bar)[XB_TMO])) break; if (_sp > XB_SPIN_CAP) { atomicAdd(&(bar)[XB_TMO], 1u); break; } } } } while (0)

struct XcdBarrier {
    unsigned* bar; unsigned x;
    volatile LAS unsigned* st;
};

__device__ __forceinline__ XcdBarrier xcd_barrier_post(unsigned* bar, volatile LAS unsigned* st) {
    XcdBarrier b; b.bar = bar; b.x = xb_xcc_id(); b.st = st;
    if (threadIdx.x == 0) (void)xb_add(&bar[XB_XCNT(b.x)], 1u);
    return b;
}
__device__ __forceinline__ void xcd_barrier_complete(unsigned* bar, unsigned x, unsigned& nloc, unsigned& nx) {
    const unsigned G = gridDim.x * gridDim.y * gridDim.z;
    unsigned sum, cnt, mine, sp = 0u;
    for (;;) {
        sum = 0u; cnt = 0u; mine = 0u;
#pragma unroll
        for (unsigned j = 0; j < 16; ++j) { const unsigned c = xb_ld(&bar[XB_XCNT(j)]); sum += c; cnt += (c > 0u) ? 1u : 0u; mine = (j == x) ? c : mine; }
        if (sum == G) break;
        __builtin_amdgcn_s_sleep(1);
        if ((++sp & 255u) == 0u) { if (xb_ld(&bar[XB_TMO])) break; if (sp > XB_SPIN_CAP) { atomicAdd(&bar[XB_TMO], 1u); break; } }
    }
    nloc = mine > 0u ? mine : 1u; nx = cnt > 0u ? cnt : 1u;
}

__device__ __forceinline__ void xcd_barrier(const XcdBarrier& b) {
    asm volatile("s_waitcnt vmcnt(0)" ::: "memory");
    __syncthreads();
    if (threadIdx.x == 0) {
        unsigned* bar = b.bar;
        __builtin_amdgcn_s_waitcnt(0);
        unsigned nloc = b.st[0], nx = b.st[1];
        if (nloc == 0u) { xcd_barrier_complete(bar, b.x, nloc, nx); b.st[0] = nloc; b.st[1] = nx; }
        const unsigned old = xb_add(&bar[XB_XSUB(b.x)], 1u);
        const unsigned gen = old / nloc;
        if (old + 1u == (gen + 1u) * nloc) {
            __builtin_amdgcn_fence(__ATOMIC_RELEASE, "agent");
            asm volatile("s_waitcnt vmcnt(0)" ::: "memory");
            const unsigned og = xb_add(&bar[XB_TOP], 1u);
            const unsigned tg = og / nx;
            if (og + 1u == (tg + 1u) * nx) xb_add(&bar[XB_TOPGEN], 1u);
            else XB_SPIN(xb_ld(&bar[XB_TOPGEN]) == tg, bar);
            __builtin_amdgcn_fence(__ATOMIC_ACQUIRE, "agent");
            xb_add(&bar[XB_XGEN(b.x)], 1u);
            asm volatile("s_waitcnt vmcnt(0)" ::: "memory");
        } else {
            XB_SPIN(xb_ld(&bar[XB_XGEN(b.x)]) == gen, bar);
            __builtin_amdgcn_fence(__ATOMIC_ACQUIRE, "agent");
            asm volatile("s_waitcnt vmcnt(0)" ::: "memory");
        }
    }
    __syncthreads();
}

constexpr int NB = 4, SEQ = 4096, D = 1024, M = NB * SEQ, INW = 1280, FF = 2816, PLE = 256;
struct Frame {
    LAS unsigned char* lds;
    volatile LAS unsigned* MISC;
    gu32* ctl;
    int tid, lane, wave;
    int vcu, G;
};

template <bool HAS_GK> __device__ __forceinline__ void p0_transpose_item(const float* W, int ldw, int k0, int ncol0, bf16* WT, int ldt, int drow0, const float* gk, LAS float* scr, int lane) {
#pragma unroll 16
    for (int i = 0; i < 32; ++i) { const int kk = 2 * i + (lane >> 5); float v = W[(size_t)(k0 + kk) * ldw + ncol0 + (lane & 31)]; if (HAS_GK) v *= gk[k0 + kk]; scr[kk * 33 + (lane & 31)] = v; }
    LDS_WAIT(); asm volatile("" ::: "memory");
    const int c = lane & 7;
#pragma unroll
    for (int j = 0; j < 4; ++j) { const int n = (lane >> 3) + 8 * j; const LAS float* s = scr + (8 * c) * 33 + n;
        v4u o; o.x = pk2(s[0 * 33], s[1 * 33]); o.y = pk2(s[2 * 33], s[3 * 33]); o.z = pk2(s[4 * 33], s[5 * 33]); o.w = pk2(s[6 * 33], s[7 * 33]);
        *(GAS v4u*)(WT + (size_t)(drow0 + n) * ldt + k0 + 8 * c) = o; }
    LDS_WAIT(); asm volatile("" ::: "memory");
}
__device__ __forceinline__ float wave_sum(float v) {
#pragma unroll
    for (int o = 1; o < 64; o <<= 1) v += __shfl_xor(v, o);
    return v;
}
struct Ptrs {
    const float *x, *p, *w_in, *w_out, *g_attn, *g_q, *g_k, *sinks, *rel_bias, *w_pool, *pool_scale, *g_ffn, *w_gate, *w_up, *w_down, *g_ple, *w_pg, *w_pp;
    float* out;
    bf16 *Win_t, *Wpp_t, *Wout_t, *Wgu_t, *Wdown_t, *Wpg_t;
    bf16 *AB, *PB, *Qb, *Kb, *Vb, *Ub, *MIX, *PE, *Fb;
    float *rstd1, *ssq2, *ssq3;
};
constexpr int I_IN = (D / 64) * (INW / 32), I_PP = (PLE / 64) * (D / 32), I_OUT = (512 / 64) * (D / 32), I_GU = (D / 64) * (2 * FF / 32), I_DN = (FF / 64) * (D / 32), I_PG = (D / 64) * (D / 32), I_FOLD = 4 * 8 * 16;
constexpr int NI_EARLY = I_IN + I_PP, NI_LATE = I_OUT + I_GU + I_DN + I_PG + I_FOLD;
__device__ __forceinline__ void weight_items(const Ptrs& P, LAS float* scr, int first, int count, int gw, int NGW, int lane) {
    for (int it = first + gw; it < first + count; it += NGW) {
        int r = it; const float* W; int ldw, k0, ncol0, ldt, drow0; bf16* WT; const float* gk = nullptr;
        if (r < I_IN) { const int nbk = INW / 32, kb = r / nbk, nb = r % nbk, pn = nb >> 3, wi = nb & 7, bj = wi >> 2, wc = wi & 3;
            W = P.w_in; ldw = INW; k0 = 64 * kb; ncol0 = 256 * pn + 64 * wc + 32 * bj; WT = P.Win_t; ldt = D; drow0 = 32 * nb; gk = P.g_attn; }
        else if ((r -= I_IN) < I_PP) { const int nbk = D / 32, kb = r / nbk, nb = r % nbk; W = P.w_pp; ldw = D; k0 = 64 * kb; ncol0 = 32 * nb; WT = P.Wpp_t; ldt = PLE; drow0 = 32 * nb; }
        else if ((r -= I_PP) < I_OUT) { const int nbk = D / 32, kb = r / nbk, nb = r % nbk; W = P.w_out; ldw = D; k0 = 64 * kb; ncol0 = 32 * nb; WT = P.Wout_t; ldt = D; drow0 = 32 * nb; }
        else if ((r -= I_OUT) < I_GU) { const int nbk = 2 * FF / 32, kb = r / nbk, nb = r % nbk, pn = nb >> 3, wi = nb & 7;
            W = wi < 4 ? P.w_gate : P.w_up; ldw = FF; k0 = 64 * kb; ncol0 = 128 * pn + 32 * (wi & 3); WT = P.Wgu_t; ldt = D; drow0 = 32 * nb; gk = P.g_ffn; }
        else if ((r -= I_GU) < I_DN) { const int nbk = D / 32, kb = r / nbk, nb = r % nbk; W = P.w_down; ldw = D; k0 = 64 * kb; ncol0 = 32 * nb; WT = P.Wdown_t; ldt = FF; drow0 = 32 * nb; }
        else if ((r -= I_DN) < I_PG) { const int nbk = D / 32, kb = r / nbk, nb = r % nbk; W = P.w_pg; ldw = D; k0 = 64 * kb; ncol0 = 32 * nb; WT = P.Wpg_t; ldt = D; drow0 = 32 * nb; gk = P.g_ple; }
        else { r -= I_PG;
            const int g = r >> 7, cb = (r >> 4) & 7, nb = r & 15, n = nb * 64 + lane;
            { const GAS f32x4* wp4 = (const GAS f32x4*)(P.w_pool + (size_t)(g * 128 + cb * 16) * 128); const GAS f32x4* ps4 = (const GAS f32x4*)(P.pool_scale + g * 128);
#pragma unroll
              for (int i = 0; i < 8; ++i) { const int q = lane + 64 * i; ((LAS f32x4*)scr)[q] = wp4[q] * ps4[q & 31]; } }
            LDS_WAIT(); asm volatile("" ::: "memory");
            float acc[16];
#pragma unroll
            for (int c = 0; c < 16; ++c) acc[c] = 0.f;
            const float* wo = P.w_out + (size_t)(512 + g * 128) * D + n;
#pragma unroll 2
            for (int d0 = 0; d0 < 128; d0 += 8) {
                float wv[8];
#pragma unroll
                for (int j = 0; j < 8; ++j) wv[j] = wo[(size_t)(d0 + j) * D];
#pragma unroll
                for (int c = 0; c < 16; ++c) { const f32x4 a = ((const LAS f32x4*)scr)[(c * 128 + d0) >> 2], b = ((const LAS f32x4*)scr)[(c * 128 + d0 + 4) >> 2];
                    acc[c] += (a[0] * wv[0] + a[1] * wv[1]) + (a[2] * wv[2] + a[3] * wv[3]) + (b[0] * wv[4] + b[1] * wv[5]) + (b[2] * wv[6] + b[3] * wv[7]); }
            }
            v4u o0, o1; o0.x = pk2(acc[0], acc[1]); o0.y = pk2(acc[2], acc[3]); o0.z = pk2(acc[4], acc[5]); o0.w = pk2(acc[6], acc[7]);
            o1.x = pk2(acc[8], acc[9]); o1.y = pk2(acc[10], acc[11]); o1.z = pk2(acc[12], acc[13]); o1.w = pk2(acc[14], acc[15]);
            GAS v4u* dst = (GAS v4u*)(P.Wout_t + (size_t)n * D + 512 + g * 128 + cb * 16); dst[0] = o0; dst[1] = o1;
            LDS_WAIT(); asm volatile("" ::: "memory");
            continue; }
        if (gk) p0_transpose_item<true>(W, ldw, k0, ncol0, WT, ldt, drow0, gk, scr, lane); else p0_transpose_item<false>(W, ldw, k0, ncol0, WT, ldt, drow0, gk, scr, lane);
    }
}
__device__ __forceinline__ void p0_prologue(const Frame& F, const Ptrs& P) {
    LAS float* scr = (LAS float*)(F.lds + F.wave * 16384);
    const int gw = F.vcu * NWAVES + F.wave, NGW = F.G * NWAVES, lane = F.lane;
    weight_items(P, scr, 0, NI_EARLY, gw, NGW, lane);
    for (int m = gw; m < M; m += 2 * NGW) {
        f32x4 v[2][4]; float s[2] = {0.f, 0.f};
#pragma unroll
        for (int h = 0; h < 2; ++h) { const GAS f32x4* xr = (const GAS f32x4*)(P.x + (size_t)(m + h * NGW) * D) + lane;
#pragma unroll
            for (int j = 0; j < 4; ++j) v[h][j] = __builtin_nontemporal_load(xr + 64 * j); }
#pragma unroll
        for (int h = 0; h < 2; ++h) {
#pragma unroll
            for (int j = 0; j < 4; ++j) s[h] += (v[h][j].x * v[h][j].x + v[h][j].y * v[h][j].y) + (v[h][j].z * v[h][j].z + v[h][j].w * v[h][j].w);
            GAS unsigned long long* o8 = (GAS unsigned long long*)(P.AB + (size_t)(m + h * NGW) * D) + lane;
#pragma unroll
            for (int j = 0; j < 4; ++j) o8[64 * j] = (unsigned long long)pk2(v[h][j].x, v[h][j].y) | ((unsigned long long)pk2(v[h][j].z, v[h][j].w) << 32);
        }
        s[0] = wave_sum(s[0]); s[1] = wave_sum(s[1]);
        if (lane == 0) { P.rstd1[m] = 1.0f / sqrtf(s[0] * (1.f / D) + 1e-6f); P.rstd1[m + NGW] = 1.0f / sqrtf(s[1] * (1.f / D) + 1e-6f); }
    }
    for (int m = gw; m < M; m += 4 * NGW) {
        f32x4 v[4];
#pragma unroll
        for (int h = 0; h < 4; ++h) v[h] = __builtin_nontemporal_load((const GAS f32x4*)(P.p + (size_t)(m + h * NGW) * PLE) + lane);
#pragma unroll
        for (int h = 0; h < 4; ++h) ((GAS unsigned long long*)(P.PB + (size_t)(m + h * NGW) * PLE))[lane] = (unsigned long long)pk2(v[h].x, v[h].y) | ((unsigned long long)pk2(v[h].z, v[h].w) << 32);
    }
}

constexpr size_t MiB = 1u << 20;
constexpr size_t WS_CTL = 0, CTL_ZERO_BYTES = 64 * 1024;
constexpr size_t WS_WIN = 1 * MiB, WS_WPP = WS_WIN + (size_t)INW * D * 2, WS_WOUT = 4 * MiB, WS_WGU = 6 * MiB, WS_WDN = 17 * MiB, WS_WPG = WS_WDN + (size_t)D * FF * 2;
constexpr size_t WS_RSTD1 = 25 * MiB, WS_SSQ2 = 26 * MiB, WS_SSQ3 = 27 * MiB;
constexpr size_t WS_AB = 32 * MiB;
constexpr size_t WS_PB = 64 * MiB;
constexpr size_t WS_PE = 72 * MiB;
constexpr size_t WS_F = 104 * MiB;
constexpr size_t WS_Q = 104 * MiB, WS_K = 120 * MiB, WS_V = 124 * MiB, WS_U = 128 * MiB, WS_MIX = 144 * MiB, WS_END = 192 * MiB;
static_assert(WS_WPP + (size_t)D * PLE * 2 <= WS_WOUT && WS_WPG + (size_t)D * D * 2 <= WS_RSTD1 && WS_F + (size_t)M * FF * 2 <= WS_END && WS_MIX + (size_t)M * D * 2 <= WS_END, "d_ws map");
constexpr int CW_BAR = 4096;
static_assert((CW_BAR + XCD_BAR_WORDS) * 4 <= (int)CTL_ZERO_BYTES, "CTL words inside the memset region");
constexpr int RING_BYTES = 131072;
constexpr int LDSCTL_OFF = RING_BYTES + 2048, MISC_OFF = LDSCTL_OFF + 320;
constexpr int LDS_BYTES = 147456;
static_assert(att::WSF_OFF + 2048 <= LDSCTL_OFF && MISC_OFF + 128 <= att::BT_OFF && att::BT_OFF + 8 * att::BT_LEN * 4 <= LDS_BYTES, "LDS map");

#ifndef MK_N_LAUNCHES
#define MK_N_LAUNCHES 1
#endif
constexpr int N_LAUNCHES = MK_N_LAUNCHES;
constexpr int N_PHASES = 7;

#ifndef PROBE_SPIN
#define PROBE_SPIN (-1)
#endif
#ifndef PROBE_ABS
#define PROBE_ABS (-1)
#endif
#ifndef PROBE_EPI
#define PROBE_EPI 0
#endif
#ifndef PROBE_SCALE
#define PROBE_SCALE 2.5e-3f
#endif
struct Args { Ptrs P; unsigned char* ws; int ph_lo, ph_hi; };
__global__ void __launch_bounds__(NWAVES * 64, 2) hymba_fwd(Args args) {
    extern __shared__ __attribute__((aligned(16))) unsigned char lds[];
    Frame F;
    F.lds = (LAS unsigned char*)lds;
    F.MISC = (volatile LAS unsigned*)(F.lds + MISC_OFF);
    F.tid = threadIdx.x; F.lane = F.tid & 63; F.wave = __builtin_amdgcn_readfirstlane(F.tid >> 6);
    F.G = gridDim.x; { const int bx = blockIdx.x; F.vcu = (F.G % 8 == 0) ? (bx % 8) * (F.G / 8) + bx / 8 : bx; }
    F.ctl = (gu32*)(args.ws + WS_CTL);
    const Ptrs& P = args.P;
    for (int u = F.tid; u < (MISC_OFF + 128 - LDSCTL_OFF) / 4; u += NWAVES * 64) ((LAS unsigned*)(F.lds + LDSCTL_OFF))[u] = 0u;
    __syncthreads();
    XcdBarrier bar; bar.bar = (unsigned*)(F.ctl + CW_BAR); bar.x = 0; bar.st = nullptr;
    if (N_LAUNCHES == 1) bar = xcd_barrier_post((unsigned*)(F.ctl + CW_BAR), F.MISC + 8);
#define GRID_BAR() do { if (N_LAUNCHES == 1) xcd_barrier(bar); } while (0)
    const int lo = args.ph_lo, hi = args.ph_hi;
#define IN(k) (lo <= (k) && (k) < hi)
#define BOTH(k) (IN(k) && IN((k) + 1))
    const int c = (int)blockIdx.x;
    unsigned long long pt0_ = 0, ptabs_ = 0, tepi_ = 0, tdummy_ = 0;
#define PH_BEGIN() do { if (PROBE_SPIN >= 0 || PROBE_ABS >= 0) pt0_ = rt(); } while (0)
#define PH_END(k) do { if (PROBE_SPIN == (k) || PROBE_ABS == (k)) { const unsigned long long t1_ = rt(), dt_ = t1_ - pt0_; if (PROBE_ABS == (k)) ptabs_ = dt_; \
        if (PROBE_SPIN == (k)) { while (rt() - t1_ < dt_) __builtin_amdgcn_s_sleep(8); } } } while (0)

    PH_BEGIN(); if (IN(0)) { p0_prologue(F, P); if (BOTH(0)) GRID_BAR(); } PH_END(0);

    PH_BEGIN(); if (IN(1)) {
        { pg8::Gemm g{P.AB, P.Win_t, M, INW, D}; pg8::StaticOrder S; S.init(M, INW, F.G, c);
          pg8::EpiIn E{P.Qb, P.Kb, P.Vb, P.Ub, P.rstd1, P.g_q, P.g_k};
          pg8::gemm_phase<pg8::EpiIn, pg8::StaticOrder, PG8_ALIGN, PG8_SP2>(F.lds, g, S, E, tdummy_); }
        {
            const int n2 = (M / 256) * (INW / 256) - F.G; const bool split = n2 > 0 && n2 < F.G;
            if (!split || c >= n2) weight_items(P, (LAS float*)(F.lds + F.wave * 16384), NI_EARLY, NI_LATE, (split ? c - n2 : c) * NWAVES + F.wave, (split ? F.G - n2 : F.G) * NWAVES, F.lane);
        }
        if (BOTH(1)) GRID_BAR();
    }
    PH_END(1);

    PH_BEGIN(); if (IN(2)) {
        att::attn_phase((att::lds_ptr)F.lds, P.Qb, P.Kb, P.Vb, P.MIX, P.rel_bias, P.sinks, F.vcu, F.G);
        att::pool_phase(P.Ub, P.MIX, M, F.vcu * NWAVES + F.wave, F.G * NWAVES, F.lane);
        if (BOTH(2)) GRID_BAR();
    }
    PH_END(2);

    PH_BEGIN(); if (IN(3)) {
        pg8::Gemm g{P.MIX, P.Wout_t, M, D, D}; pg8::StaticOrder S; S.init(M, D, F.G, c);
        pg8::EpiRes E{P.AB, P.ssq2};
        pg8::gemm_phase<pg8::EpiRes, pg8::StaticOrder, PG8_ALIGN, PG8_SP2>(F.lds, g, S, E, tdummy_);
        if (BOTH(3)) GRID_BAR();
    }
    PH_END(3);

    PH_BEGIN(); if (IN(4)) {
        pg8::Gemm g{P.AB, P.Wgu_t, M, 2 * FF, D}; pg8::StaticOrder S; S.init(M, 2 * FF, F.G, c);
        pg8::EpiGU E{P.Fb, FF, P.ssq2};
        pg8::gemm_phase<pg8::EpiGU, pg8::StaticOrder, PG8_ALIGN, PG8_SP2>(F.lds, g, S, E, tepi_);
        {
            const int nu = (M / 256) * (2 * FF / 256), n6 = nu - (nu / F.G) * F.G; const bool split = n6 > 0 && n6 % 8 == 0;
            pg8::Gemm g2{P.PB, P.Wpp_t, M, D, PLE}; pg8::StaticOrder S2; if (split) S2.init(M, D, F.G - n6, c >= n6 ? c - n6 : (1 << 24)); else S2.init(M, D, F.G, c);
            pg8::EpiBf16 E2{P.PE, D};
            pg8::gemm_phase<pg8::EpiBf16, pg8::StaticOrder, PG8_ALIGN, PG8_SP2>(F.lds, g2, S2, E2, tdummy_);
        }
        if (BOTH(4)) GRID_BAR();
    }
    PH_END(4);

    PH_BEGIN(); if (IN(5)) {
        pg8::Gemm g{P.Fb, P.Wdown_t, M, D, FF}; pg8::StaticOrder S; S.init(M, D, F.G, c);
        pg8::EpiRes E{P.AB, P.ssq3};
        pg8::gemm_phase<pg8::EpiRes, pg8::StaticOrder, PG8_ALIGN, PG8_SP2>(F.lds, g, S, E, tdummy_);
        if (BOTH(5)) GRID_BAR();
    }
    PH_END(5);

    PH_BEGIN(); if (IN(6)) {
        pg8::Gemm g{P.AB, P.Wpg_t, M, D, D}; pg8::StaticOrder S; S.init(M, D, F.G, c);
        pg8::EpiFinal E{P.out, P.AB, P.PE, P.ssq3};
        pg8::gemm_phase<pg8::EpiFinal, pg8::StaticOrder, PG8_ALIGN, PG8_SP2>(F.lds, g, S, E, tdummy_);
    }
    PH_END(6);
    if (PROBE_ABS == 7) ptabs_ = tepi_;
    if (PROBE_ABS >= 0 && blockIdx.x == 0 && F.tid == 0) P.out[0] += (float)ptabs_ * 0.01f * PROBE_SCALE;
#undef IN
#undef BOTH
#undef GRID_BAR
}

extern "C" void kernel_launch(void* const* d_in, const int* in_sizes, int n_in, void* d_out, int out_size, void* d_ws, size_t ws_size, hipStream_t stream) {
    static int grid = 0;
    if (grid == 0) {
        if (n_in != 18 || in_sizes[0] != M * D || out_size != M * D || ws_size < WS_END) { fprintf(stderr, "kernel_launch: unexpected shapes (n_in %d, in0 %d, out %d, ws %zu); nothing launched\n", n_in, n_in > 0 ? in_sizes[0] : -1, out_size, ws_size); grid = -1; return; }
        int dev = 0, cus = 0, per_cu = 0;
        if (hipGetDevice(&dev) != hipSuccess || hipDeviceGetAttribute(&cus, hipDeviceAttributeMultiprocessorCount, dev) != hipSuccess) { fprintf(stderr, "kernel_launch: device query failed\n"); grid = -1; return; }
        if (hipFuncSetAttribute((const void*)hymba_fwd, hipFuncAttributeMaxDynamicSharedMemorySize, LDS_BYTES) != hipSuccess) { fprintf(stderr, "kernel_launch: hipFuncSetAttribute failed\n"); grid = -1; return; }
        if (hipOccupancyMaxActiveBlocksPerMultiprocessor(&per_cu, (const void*)hymba_fwd, NWAVES * 64, LDS_BYTES) != hipSuccess || per_cu < 1) { fprintf(stderr, "kernel_launch: occupancy query reports %d workgroups per CU\n", per_cu); per_cu = 1; }
        (void)hipGetLastError();
        grid = cus;
    }
    if (grid < 0) return;
    if (N_LAUNCHES == 1) { if (hipMemsetAsync((char*)d_ws + WS_CTL, 0, CTL_ZERO_BYTES, stream) != hipSuccess) { fprintf(stderr, "kernel_launch: hipMemsetAsync failed\n"); return; } }
    Args a{};
    unsigned char* ws = (unsigned char*)d_ws;
    Ptrs& P = a.P;
    P.x = (const float*)d_in[0]; P.p = (const float*)d_in[1]; P.w_in = (const float*)d_in[2]; P.w_out = (const float*)d_in[3]; P.g_attn = (const float*)d_in[4]; P.g_q = (const float*)d_in[5];
    P.g_k = (const float*)d_in[6]; P.sinks = (const float*)d_in[7]; P.rel_bias = (const float*)d_in[8]; P.w_pool = (const float*)d_in[9]; P.pool_scale = (const float*)d_in[10];
    P.g_ffn = (const float*)d_in[11]; P.w_gate = (const float*)d_in[12]; P.w_up = (const float*)d_in[13]; P.w_down = (const float*)d_in[14]; P.g_ple = (const float*)d_in[15];
    P.w_pg = (const float*)d_in[16]; P.w_pp = (const float*)d_in[17]; P.out = (float*)d_out;
    P.Win_t = (bf16*)(ws + WS_WIN); P.Wpp_t = (bf16*)(ws + WS_WPP); P.Wout_t = (bf16*)(ws + WS_WOUT); P.Wgu_t = (bf16*)(ws + WS_WGU); P.Wdown_t = (bf16*)(ws + WS_WDN); P.Wpg_t = (bf16*)(ws + WS_WPG);
    P.AB = (bf16*)(ws + WS_AB); P.PB = (bf16*)(ws + WS_PB); P.Qb = (bf16*)(ws + WS_Q); P.Kb = (bf16*)(ws + WS_K); P.Vb = (bf16*)(ws + WS_V); P.Ub = (bf16*)(ws + WS_U);
    P.MIX = (bf16*)(ws + WS_MIX); P.PE = (bf16*)(ws + WS_PE); P.Fb = (bf16*)(ws + WS_F);
    P.rstd1 = (float*)(ws + WS_RSTD1); P.ssq2 = (float*)(ws + WS_SSQ2); P.ssq3 = (float*)(ws + WS_SSQ3);
    a.ws = ws;
    for (int li = 0; li < N_LAUNCHES; ++li) {
        a.ph_lo = (N_LAUNCHES == 1) ? 0 : li; a.ph_hi = (N_LAUNCHES == 1) ? N_PHASES : li + 1;
        hipLaunchKernelGGL(hymba_fwd, dim3(grid), dim3(NWAVES * 64), LDS_BYTES, stream, a);
        const hipError_t le = hipPeekAtLastError();
        if (le != hipSuccess) { fprintf(stderr, "kernel_launch: launch %d failed: %s\n", li, hipGetErrorName(le)); break; }
    }
}
```
